# Optimizing an MI355X kernel written in HIP

```python
import math
import jax, jax.numpy as jnp
from jax import lax
import numpy as np

D_MODEL = 2048
BATCH = 2
SEQ = 8192
DEPTH = 2

N_MIXERS = 2
N_A_LAYERS = (DEPTH + 1) // 2
N_B_LAYERS = DEPTH // 2
EPS = 1e-6

M_HEADS = 8
M_QK_DIM = D_MODEL // 2
M_V_DIM = D_MODEL
M_DK = M_QK_DIM // M_HEADS
M_DV = M_V_DIM // M_HEADS
M_PROJ = 2 * M_QK_DIM + 2 * M_V_DIM + 2 * M_HEADS
M_CHUNK = 64

R_WIDTH = D_MODEL
R_BLOCKS = 8
R_BLOCK_W = R_WIDTH // R_BLOCKS
R_CONV_W = 4
R_C = 8.0

D_FF = ((8 * D_MODEL // 3 + 255) // 256) * 256

kernel_name = "hybrid_mlstm_rglru_interleaved"


def rms_norm(x, g):
    xf = x.astype(jnp.float32)
    y = xf * lax.rsqrt(jnp.mean(xf * xf, axis=-1, keepdims=True) + EPS)
    return (y * g.astype(jnp.float32)).astype(x.dtype)


def swiglu(x, w_in, w_out):
    g, u = jnp.split(x @ w_in, 2, axis=-1)
    return (jax.nn.silu(g) * u) @ w_out


def mlstm_chunkwise(q, k, v, ig, lf):
    B, H, S, DK = q.shape
    DV = v.shape[-1]
    nc = S // M_CHUNK

    def to_chunks(t):
        return jnp.moveaxis(t.reshape(B, H, nc, M_CHUNK, *t.shape[3:]), 2, 0)

    qc, kc, vc, ic, fc = (to_chunks(t) for t in (q, k, v, ig, lf))
    causal = jnp.tril(jnp.ones((M_CHUNK, M_CHUNK), dtype=bool))

    def step(carry, xs):
        C, n, m = carry
        qb, kb, vb, ib, fb = xs
        b = jnp.cumsum(fb, axis=-1)
        dmat = b[..., :, None] - b[..., None, :] + ib[..., None, :]
        dmat = jnp.where(causal, dmat, -jnp.inf)
        m_inter = b + m[..., None]
        m_t = jnp.maximum(m_inter, jnp.max(dmat, axis=-1))
        w = jnp.exp(dmat - m_t[..., None])
        s = jnp.einsum('bhtd,bhsd->bhts', qb, kb) * w
        scale_inter = jnp.exp(m_inter - m_t)
        num = (jnp.einsum('bhts,bhsv->bhtv', s, vb)
               + scale_inter[..., None] * jnp.einsum('bhtd,bhdv->bhtv', qb, C))
        den = jnp.sum(s, axis=-1) + scale_inter * jnp.einsum('bhtd,bhd->bht', qb, n)
        h = num / jnp.maximum(jnp.abs(den), jnp.exp(-m_t))[..., None]
        b_last = b[..., -1]
        g = b_last[..., None] - b + ib
        m_new = jnp.maximum(b_last + m, jnp.max(g, axis=-1))
        wk = jnp.exp(g - m_new[..., None])
        decay = jnp.exp(b_last + m - m_new)
        kw = kb * wk[..., None]
        C_new = decay[..., None, None] * C + jnp.einsum('bhsd,bhsv->bhdv', kw, vb)
        n_new = decay[..., None] * n + jnp.sum(kw, axis=-2)
        return (C_new, n_new, m_new), h

    init = (jnp.zeros((B, H, DK, DV), jnp.float32),
            jnp.zeros((B, H, DK), jnp.float32),
            jnp.zeros((B, H), jnp.float32))
    _, hc = lax.scan(step, init, (qc, kc, vc, ic, fc))
    return jnp.moveaxis(hc, 0, 2).reshape(B, H, S, DV)


def mlstm_mixer(x, w_in, b_if, head_norm, w_out):
    B, S, _ = x.shape
    proj = x @ w_in
    q, k, v, o, if_pre = jnp.split(
        proj, [M_QK_DIM, 2 * M_QK_DIM, 2 * M_QK_DIM + M_V_DIM, 2 * M_QK_DIM + 2 * M_V_DIM], axis=-1)

    def heads(t, d):
        return t.reshape(B, S, M_HEADS, d).transpose(0, 2, 1, 3).astype(jnp.float32)

    qh = heads(q, M_DK)
    kh = heads(k, M_DK) * (M_DK ** -0.5)
    vh = heads(v, M_DV)
    gates = (if_pre + b_if).astype(jnp.float32).reshape(B, S, 2, M_HEADS)
    ig = gates[:, :, 0].transpose(0, 2, 1)
    lf = jax.nn.log_sigmoid(gates[:, :, 1]).transpose(0, 2, 1)
    h = mlstm_chunkwise(qh, kh, vh, ig, lf)
    h = h * lax.rsqrt(jnp.mean(h * h, axis=-1, keepdims=True) + EPS)
    h = h.transpose(0, 2, 1, 3).reshape(B, S, M_V_DIM) * head_norm.astype(jnp.float32)
    h = h * jax.nn.sigmoid(o.astype(jnp.float32))
    return h.astype(x.dtype) @ w_out


def causal_depthwise_conv(x, w, b):
    C = x.shape[-1]
    y = lax.conv_general_dilated(
        x, w[:, None, :].astype(x.dtype), window_strides=(1,),
        padding=[(R_CONV_W - 1, 0)], dimension_numbers=('NWC', 'WIO', 'NWC'),
        feature_group_count=C)
    return y + b


def rglru_mixer(x, w_in, conv_w, conv_b, gate_w, gate_b, a_param, w_out):
    B, S, _ = x.shape
    gate_branch, rec = jnp.split(x @ w_in, 2, axis=-1)
    rec = causal_depthwise_conv(rec, conv_w, conv_b)
    xb = rec.reshape(B, S, R_BLOCKS, R_BLOCK_W)
    gates = jnp.einsum('bsgi,gio->bsgo', xb, gate_w) + gate_b
    r_pre, i_pre = jnp.split(gates.astype(jnp.float32), 2, axis=-1)
    r = jax.nn.sigmoid(r_pre).reshape(B, S, R_WIDTH)
    i = jax.nn.sigmoid(i_pre).reshape(B, S, R_WIDTH)
    log_a = R_C * r * jax.nn.log_sigmoid(a_param.astype(jnp.float32))
    a = jnp.exp(log_a)
    mult = jnp.sqrt(-jnp.expm1(2.0 * log_a))
    u = mult * (i * rec.astype(jnp.float32))

    def combine(left, right):
        a1, b1 = left
        a2, b2 = right
        return a2 * a1, a2 * b1 + b2

    _, h = lax.associative_scan(combine, (a, u), axis=1)
    y = jax.nn.gelu(gate_branch.astype(jnp.float32)) * h
    return y.astype(x.dtype) @ w_out


def setup_inputs(seed: int = 0) -> dict:
    key = jax.random.key(seed)
    ks = jax.random.split(key, 20)
    f32 = jnp.float32

    def nrm(k, shape, scale):
        return jax.random.normal(k, shape, f32) * scale

    x = jax.random.normal(ks[0], (BATCH, SEQ, D_MODEL), f32)
    norm_mix = 1.0 + nrm(ks[1], (DEPTH, D_MODEL), 0.02)
    norm_ffn = 1.0 + nrm(ks[2], (DEPTH, D_MODEL), 0.02)
    norm_final = 1.0 + nrm(ks[3], (D_MODEL,), 0.02)

    m_w_in = nrm(ks[4], (N_A_LAYERS, D_MODEL, M_PROJ), D_MODEL ** -0.5)
    kb1, kb2 = jax.random.split(ks[5])
    m_b_if = jnp.concatenate([nrm(kb1, (N_A_LAYERS, M_HEADS), 0.1),
                              3.0 + nrm(kb2, (N_A_LAYERS, M_HEADS), 0.1)], axis=-1)
    m_head_norm = 1.0 + nrm(ks[6], (N_A_LAYERS, M_V_DIM), 0.02)
    m_w_out = nrm(ks[7], (N_A_LAYERS, M_V_DIM, D_MODEL), M_V_DIM ** -0.5)

    r_w_in = nrm(ks[8], (N_B_LAYERS, D_MODEL, 2 * R_WIDTH), D_MODEL ** -0.5)
    r_conv_w = nrm(ks[9], (N_B_LAYERS, R_CONV_W, R_WIDTH), R_CONV_W ** -0.5)
    r_conv_b = nrm(ks[10], (N_B_LAYERS, R_WIDTH), 0.02)
    r_gate_w = nrm(ks[11], (N_B_LAYERS, R_BLOCKS, R_BLOCK_W, 2 * R_BLOCK_W), R_BLOCK_W ** -0.5)
    r_gate_b = nrm(ks[12], (N_B_LAYERS, R_BLOCKS, 2 * R_BLOCK_W), 0.02)
    a_c = jax.random.uniform(ks[13], (N_B_LAYERS, R_WIDTH), f32, 0.9, 0.999)
    a_base = a_c ** (1.0 / R_C)
    r_a_param = jnp.log(a_base) - jnp.log1p(-a_base)
    r_w_out = nrm(ks[14], (N_B_LAYERS, R_WIDTH, D_MODEL), R_WIDTH ** -0.5)

    ffn_w_in = nrm(ks[15], (DEPTH, D_MODEL, 2 * D_FF), D_MODEL ** -0.5)
    ffn_w_out = nrm(ks[16], (DEPTH, D_FF, D_MODEL), D_FF ** -0.5)

    return {"x": x, "norm_mix": norm_mix, "norm_ffn": norm_ffn, "norm_final": norm_final,
            "m_w_in": m_w_in, "m_b_if": m_b_if, "m_head_norm": m_head_norm, "m_w_out": m_w_out,
            "r_w_in": r_w_in, "r_conv_w": r_conv_w, "r_conv_b": r_conv_b, "r_gate_w": r_gate_w,
            "r_gate_b": r_gate_b, "r_a_param": r_a_param, "r_w_out": r_w_out,
            "ffn_w_in": ffn_w_in, "ffn_w_out": ffn_w_out}


def reference(x, norm_mix, norm_ffn, norm_final, m_w_in, m_b_if, m_head_norm, m_w_out,
              r_w_in, r_conv_w, r_conv_b, r_gate_w, r_gate_b, r_a_param, r_w_out,
              ffn_w_in, ffn_w_out):
    h = x
    for layer in range(DEPTH):
        hn = rms_norm(h, norm_mix[layer])
        j = layer // N_MIXERS
        if layer % N_MIXERS == 0:
            mix = mlstm_mixer(hn, m_w_in[j], m_b_if[j], m_head_norm[j], m_w_out[j])
        else:
            mix = rglru_mixer(hn, r_w_in[j], r_conv_w[j], r_conv_b[j], r_gate_w[j],
                              r_gate_b[j], r_a_param[j], r_w_out[j])
        h = h + mix
        h = h + swiglu(rms_norm(h, norm_ffn[layer]), ffn_w_in[layer], ffn_w_out[layer])
    return rms_norm(h, norm_final)
```

```cpp
#include <hip/hip_runtime.h>
#include <hip/hip_cooperative_groups.h>
#include <cstdio>
namespace cg = cooperative_groups;

namespace pg8 {
#define PG8_LAS __attribute__((address_space(3)))
typedef unsigned short bf16_t;
typedef short bf16x8 __attribute__((ext_vector_type(8)));
typedef float f32x4 __attribute__((ext_vector_type(4)));
typedef unsigned u32x4 __attribute__((ext_vector_type(4)));
constexpr int BM = 256, BK = 64, HALF = 128, HTB = HALF * BK * 2  , STAGE_BYTES = 8 * HTB, NXCD = 8, WGM = 8;

__host__ __device__ __forceinline__ int lds_byte(int r, int c) { const int st = (r >> 4) * 2 + (c >> 5), rr = r & 15, cc = c & 31, ob = rr * 64 + cc * 2; return st * 1024 + (ob ^ (((ob >> 9) & 1) << 5)); }
__host__ __device__ __forceinline__ void stage_rc(int b, int& R, int& C) { const int st = b / 1024, sb = b % 1024, swz = sb ^ (((sb >> 9) & 1) << 5); R = (st >> 1) * 16 + swz / 64; C = (st & 1) * 32 + (swz % 64) / 2; }
__host__ __device__ __forceinline__ int perm32(int rho) { const int n = rho >> 4, i = rho & 15; return 8 * (i >> 2) + 4 * n + (i & 3); }
struct Unit { int pm, pn, aoff; };
struct Gemm { const bf16_t* A; const bf16_t* Bt; int M, N, K, lda, ldb, wave; };
struct StaticOrder {
    int nM, nN, nwg, G, c;
    __host__ __device__ void init(int M, int N, int G_, int c_) { nM = M / BM; nN = N / BM; nwg = nM * nN; G = G_; c = c_; }
    __host__ __device__ bool next(int i, Unit& u) const {
        const long L = (long)i * G + c; if (L >= nwg) return false;
        int wgid = (int)L; { const int q = nwg / NXCD, r = nwg % NXCD, xcd = wgid % NXCD, off = wgid / NXCD; wgid = (xcd < r ? xcd * (q + 1) : r * (q + 1) + (xcd - r) * q) + off; }
        const int nig = WGM * nN, gid = wgid / nig, fm = gid * WGM, gsz = (nM - fm) < WGM ? (nM - fm) : WGM;
        u.pm = fm + ((wgid % nig) % gsz); u.pn = (wgid % nig) / gsz; u.aoff = 0; return true;
    }
    __device__ __forceinline__ void a_ready(const Unit&) const {}
    __device__ __forceinline__ void done(const Unit&) const {}
};
__device__ __forceinline__ unsigned cvt_pk_bf16(float lo, float hi) { unsigned r; asm volatile("v_cvt_pk_bf16_f32 %0, %1, %2" : "=v"(r) : "v"(lo), "v"(hi)); return r; }
typedef float f32x2 __attribute__((ext_vector_type(2)));
template <class Epi, class Sched, bool ALIGN_EPI = false, bool SP2 = false>
__device__ __forceinline__ void gemm_phase(PG8_LAS unsigned char* lds, const Gemm g, const Sched& S, const Epi& E) {
    int lane_ = __builtin_amdgcn_mbcnt_hi(~0u, __builtin_amdgcn_mbcnt_lo(~0u, 0u)); asm volatile("" : "+v"(lane_));
    const int wid = g.wave, tid = wid * 64 + lane_, lane = tid & 63, wr = wid >> 2, wc = wid & 3, fr = lane & 15, fq = lane >> 4;
    const int K = g.K, nt = K / BK;
    unsigned voffA[2], voffB[2];
#pragma unroll
    for (int i = 0; i < 2; ++i) { int R, C; stage_rc(tid * 16 + i * 8192, R, C); const int Rb = Epi::PERM ? ((R & ~31) + perm32(R & 31)) : R;
        voffA[i] = (unsigned)(R * g.lda + C) * 2u; voffB[i] = (unsigned)(Rb * g.ldb + C) * 2u; }
    constexpr unsigned kstep = (unsigned)(BK * 2);
    const unsigned hstepA = (unsigned)HALF * g.lda * 2u, hstepB = (unsigned)HALF * g.ldb * 2u;
    const unsigned tstepA = 2u * hstepA, tstepB = 2u * hstepB;
    const unsigned ldsw = (unsigned)wid * 1024u;
    const int aoff = lds_byte(wr * 64 + fr, fq * 8), boff = lds_byte(wc * 32 + fr, fq * 8);
#define PG8_SA(b, h) (((b) * 2 + (h)) * HTB)
#define PG8_SB(b, h) ((4 + (b) * 2 + (h)) * HTB)
#define PG8_STAGE(bufoff, gbase, voff) do { _Pragma("unroll") for (int _i = 0; _i < 2; ++_i) \
        __builtin_amdgcn_global_load_lds((const unsigned*)((const char*)(gbase) + (voff)[_i]), (PG8_LAS unsigned*)(lds + (bufoff) + ldsw + _i * 8192), 16, 0, 0); } while (0)
#define PG8_LDA(dst, b, h) do { _Pragma("unroll") for (int m = 0; m < 4; ++m) _Pragma("unroll") for (int k = 0; k < 2; ++k) dst[m][k] = *(const PG8_LAS bf16x8*)(lds + PG8_SA(b, h) + aoff + m * 2048 + k * 1024); } while (0)
#define PG8_LDB(dst, b, h) do { _Pragma("unroll") for (int n = 0; n < 2; ++n) _Pragma("unroll") for (int k = 0; k < 2; ++k) dst[n][k] = *(const PG8_LAS bf16x8*)(lds + PG8_SB(b, h) + boff + n * 2048 + k * 1024); } while (0)
#define PG8_MMA(ai, bj, At, Bt) do { __builtin_amdgcn_s_setprio(1); _Pragma("unroll") for (int m = 0; m < 4; ++m) _Pragma("unroll") for (int n = 0; n < 2; ++n) _Pragma("unroll") for (int k = 0; k < 2; ++k) \
        acc[ai][bj][m][n] = __builtin_amdgcn_mfma_f32_16x16x32_bf16(Bt[n][k], At[m][k], acc[ai][bj][m][n], 0, 0, 0); __builtin_amdgcn_s_setprio(0); } while (0)
#define PG8_WAIT_V(n) asm volatile("s_waitcnt vmcnt(" #n ")" ::: "memory")
#define PG8_WAIT_L(n) asm volatile("s_waitcnt lgkmcnt(" #n ")" ::: "memory")
#define PG8_BAR __builtin_amdgcn_s_barrier()
#define PG8_SCHED __builtin_amdgcn_sched_barrier(0)
    Unit cur, nxt; int ui = 0;
    if (!S.next(0, cur)) return;
    f32x4 acc[2][2][4][2];
#pragma unroll
    for (int a = 0; a < 2; ++a)
#pragma unroll
        for (int b = 0; b < 2; ++b)
#pragma unroll
            for (int m = 0; m < 4; ++m)
#pragma unroll
                for (int n = 0; n < 2; ++n) acc[a][b][m][n] = (f32x4){0.f, 0.f, 0.f, 0.f};
    bf16x8 At[4][2], B0[2][2], B1[2][2];
    const char* cA = (const char*)g.A + (size_t)cur.pm * tstepA + cur.aoff; const char* cB = (const char*)g.Bt + (size_t)cur.pn * tstepB;
    S.a_ready(cur);
    if constexpr (SP2) {
        PG8_STAGE(PG8_SB(0, 0), cB, voffB); PG8_STAGE(PG8_SB(0, 1), cB + hstepB, voffB); PG8_STAGE(PG8_SA(0, 0), cA, voffA); PG8_STAGE(PG8_SA(0, 1), cA + hstepA, voffA);
        if (wr == 1) PG8_BAR;
        PG8_WAIT_V(2); PG8_BAR;
        PG8_STAGE(PG8_SB(1, 0), cB + kstep, voffB); PG8_STAGE(PG8_SA(1, 0), cA + kstep, voffA); PG8_STAGE(PG8_SB(1, 1), cB + hstepB + kstep, voffB);
        PG8_WAIT_V(6); PG8_BAR;
    } else {
        PG8_STAGE(PG8_SB(0, 0), cB, voffB); PG8_STAGE(PG8_SA(0, 0), cA, voffA); PG8_STAGE(PG8_SB(0, 1), cB + hstepB, voffB); PG8_STAGE(PG8_SA(0, 1), cA + hstepA, voffA);
        if (wr == 1) PG8_BAR;
        PG8_WAIT_V(4); PG8_BAR;
        PG8_STAGE(PG8_SB(1, 0), cB + kstep, voffB); PG8_STAGE(PG8_SA(1, 0), cA + kstep, voffA); PG8_STAGE(PG8_SB(1, 1), cB + hstepB + kstep, voffB);
        PG8_WAIT_V(6); PG8_BAR;
    }
    for (;;) {
        const bool has_next = S.next(ui + 1, nxt);
        const char* nA = has_next ? (const char*)g.A + (size_t)nxt.pm * tstepA + nxt.aoff : cA; const char* nB = has_next ? (const char*)g.Bt + (size_t)nxt.pn * tstepB : cB;
        for (int t = 0; t < nt; t += 2) {
            const bool last = (t == nt - 2);
            const char* a1 = cA + (size_t)(t + 1) * kstep;
            const char* a2 = last ? nA : cA + (size_t)(t + 2) * kstep; const char* b2 = last ? nB : cB + (size_t)(t + 2) * kstep;
            const char* a3 = a2 + kstep; const char* b3 = b2 + kstep;
            if (last && has_next) S.a_ready(nxt);
            if constexpr (SP2) {
            PG8_LDB(B0, 0, 0); PG8_LDB(B1, 0, 1); PG8_SCHED; PG8_LDA(At, 0, 0); PG8_STAGE(PG8_SA(1, 1), a1 + hstepA, voffA);
            PG8_WAIT_V(8); PG8_WAIT_L(0); PG8_BAR; PG8_MMA(0, 0, At, B0); PG8_MMA(0, 1, At, B1); PG8_BAR; PG8_SCHED;
            PG8_LDA(At, 0, 1); PG8_STAGE(PG8_SB(0, 0), b2, voffB); PG8_STAGE(PG8_SB(0, 1), b2 + hstepB, voffB); PG8_STAGE(PG8_SA(0, 0), a2, voffA);
            PG8_WAIT_V(8); PG8_WAIT_L(0); PG8_BAR; PG8_MMA(1, 0, At, B0); PG8_MMA(1, 1, At, B1); PG8_BAR; PG8_SCHED;
            PG8_LDB(B0, 1, 0); PG8_LDB(B1, 1, 1); PG8_SCHED; PG8_LDA(At, 1, 0); PG8_STAGE(PG8_SA(0, 1), a2 + hstepA, voffA);
            PG8_WAIT_V(8); PG8_WAIT_L(0); PG8_BAR; PG8_MMA(0, 0, At, B0); PG8_MMA(0, 1, At, B1); PG8_BAR; PG8_SCHED;
            PG8_LDA(At, 1, 1); PG8_STAGE(PG8_SB(1, 0), b3, voffB); PG8_STAGE(PG8_SB(1, 1), b3 + hstepB, voffB); PG8_STAGE(PG8_SA(1, 0), a3, voffA);
            PG8_WAIT_V(8); PG8_WAIT_L(0); PG8_BAR; PG8_MMA(1, 0, At, B0); PG8_MMA(1, 1, At, B1); PG8_BAR; PG8_SCHED;
            } else {
            PG8_LDB(B0, 0, 0); PG8_SCHED; PG8_LDA(At, 0, 0); PG8_STAGE(PG8_SA(1, 1), a1 + hstepA, voffA);
            PG8_WAIT_L(8); PG8_BAR; PG8_WAIT_L(0); PG8_MMA(0, 0, At, B0); PG8_BAR; PG8_SCHED;
            PG8_LDB(B1, 0, 1); PG8_STAGE(PG8_SB(0, 0), b2, voffB);
            PG8_BAR; PG8_WAIT_L(0); PG8_MMA(0, 1, At, B1); PG8_BAR;
            PG8_LDA(At, 0, 1); PG8_STAGE(PG8_SA(0, 0), a2, voffA);
            PG8_BAR; PG8_WAIT_L(0); PG8_MMA(1, 0, At, B0); PG8_BAR; PG8_SCHED;
            PG8_STAGE(PG8_SB(0, 1), b2 + hstepB, voffB);
            PG8_WAIT_V(6); PG8_BAR; PG8_MMA(1, 1, At, B1); PG8_BAR;
            PG8_LDB(B0, 1, 0); PG8_SCHED; PG8_LDA(At, 1, 0); PG8_STAGE(PG8_SA(0, 1), a2 + hstepA, voffA);
            PG8_WAIT_L(8); PG8_BAR; PG8_WAIT_L(0); PG8_MMA(0, 0, At, B0); PG8_BAR; PG8_SCHED;
            PG8_LDB(B1, 1, 1); PG8_STAGE(PG8_SB(1, 0), b3, voffB);
            PG8_BAR; PG8_WAIT_L(0); PG8_MMA(0, 1, At, B1); PG8_BAR;
            PG8_LDA(At, 1, 1); PG8_STAGE(PG8_SA(1, 0), a3, voffA);
            PG8_BAR; PG8_WAIT_L(0); PG8_MMA(1, 0, At, B0); PG8_BAR; PG8_SCHED;
            PG8_STAGE(PG8_SB(1, 1), b3 + hstepB, voffB);
            PG8_WAIT_V(6); PG8_BAR; PG8_MMA(1, 1, At, B1); PG8_BAR;
            }
        }
        if constexpr (ALIGN_EPI) { if (wr == 0) PG8_BAR; }
        if constexpr (!Epi::AFTER_DRAIN) { int ln_ = __builtin_amdgcn_mbcnt_hi(~0u, __builtin_amdgcn_mbcnt_lo(~0u, 0u)); asm volatile("" : "+v"(ln_)); E(acc, cur, wr, wc, ln_ & 15, ln_ >> 4); S.done(cur); }
        if (!has_next) break;
#pragma unroll
        for (int a = 0; a < 2; ++a)
#pragma unroll
            for (int b = 0; b < 2; ++b)
#pragma unroll
                for (int m = 0; m < 4; ++m)
#pragma unroll
                    for (int n = 0; n < 2; ++n) acc[a][b][m][n] = (f32x4){0.f, 0.f, 0.f, 0.f};
        cur = nxt; cA = nA; cB = nB; ++ui;
        if constexpr (ALIGN_EPI) { if (wr == 1) PG8_BAR; }
    }
    PG8_WAIT_V(0);
    if constexpr (!ALIGN_EPI) { if (wr == 0) PG8_BAR; }
    PG8_BAR;
    if constexpr (Epi::AFTER_DRAIN) { E.fused(acc, cur, wr, wc, fr, fq, lds, wid, lane); S.done(cur); }
#undef PG8_SA
#undef PG8_SB
#undef PG8_STAGE
#undef PG8_LDA
#undef PG8_LDB
#undef PG8_MMA
#undef PG8_WAIT_V
#undef PG8_WAIT_L
#undef PG8_BAR
#undef PG8_SCHED
}

typedef unsigned u32x2 __attribute__((ext_vector_type(2)));
constexpr float RMS_EPS = 1e-6f;
__device__ __forceinline__ float shx(float v, int mask, int lane) { return __int_as_float(__builtin_amdgcn_ds_bpermute((lane ^ mask) << 2, __float_as_int(v))); }
__device__ __forceinline__ float shi(float v, int src) { return __int_as_float(__builtin_amdgcn_ds_bpermute(src << 2, __float_as_int(v))); }
__device__ __forceinline__ float sigmoidf_(float x) { return __builtin_amdgcn_rcpf(1.0f + __expf(-x)); }
__device__ __forceinline__ float logsigmoidf_(float x) { const float e = __expf(-fabsf(x)), u = 1.0f + e, d = u - 1.0f; const float l = (d == 0.f) ? e : __logf(u) * (e * __builtin_amdgcn_rcpf(d)); return fminf(x, 0.f) - l; }
__device__ __forceinline__ float one_minus_exp(float y) { const float a = 1.0f - __expf(y), b = -y * (1.0f + y * (0.5f + y * (1.0f / 6.0f))); return (y > -0.01f) ? b : a; }
__device__ __forceinline__ float gelu_tanh(float x) { const float p = __builtin_fmaf(x * x, -0.10294325f, -2.3022082f); return x * __builtin_amdgcn_rcpf(1.0f + __builtin_amdgcn_exp2f(x * p)); }
__device__ __forceinline__ float bf_lo(unsigned w) { return __uint_as_float(w << 16); }
__device__ __forceinline__ float bf_hi(unsigned w) { return __uint_as_float(w & 0xffff0000u); }

__device__ __forceinline__ float row_rstd(const float* ssqp, int row, int fr, int fq) {
    const f32x4 p0 = *(const f32x4*)(ssqp + (size_t)row * 32 + fq * 8), p1 = *(const f32x4*)(ssqp + (size_t)row * 32 + fq * 8 + 4);
    float t = ((p0[0] + p0[1]) + (p0[2] + p0[3])) + ((p1[0] + p1[1]) + (p1[2] + p1[3])); const int ln = fr + 16 * fq;
    t += shx(t, 16, ln); t += shx(t, 32, ln);
    return rsqrtf(t * (1.0f / 2048.0f) + RMS_EPS);
}
struct EpiMlstmIn {
    static constexpr bool PERM = true, AFTER_DRAIN = false;
    bf16_t *Q, *Kb, *V, *O; const float* ssq;
    __device__ __forceinline__ void operator()(const f32x4 (&acc)[2][2][4][2], const Unit& u, int wr, int wc, int fr, int fq) const {
        const int row0 = u.pm * BM + wr * 64 + fr; const int pn = u.pn;
        bf16_t* base; int ldc, colt; bool sig = false;
        if (pn < 4) { base = Q; ldc = 1024; colt = pn * BM; } else if (pn < 8) { base = Kb; ldc = 1024; colt = (pn - 4) * BM; }
        else if (pn < 16) { base = V; ldc = 2048; colt = (pn - 8) * BM; } else { base = O; ldc = 2048; colt = (pn - 16) * BM; sig = true; }
        const int col0 = colt + wc * 32 + 8 * fq;
#pragma unroll
        for (int ai = 0; ai < 2; ++ai)
#pragma unroll
            for (int m = 0; m < 4; ++m) { const int row = row0 + ai * HALF + m * 16; const float rs = row_rstd(ssq, row, fr, fq);
                bf16_t* rowp = base + (size_t)row * ldc + col0;
#pragma unroll
                for (int bj = 0; bj < 2; ++bj) { f32x4 v0, v1;
                    if (sig) { const float nr = -1.4426950408889634f * rs;
#pragma unroll
                        for (int j = 0; j < 4; ++j) { v0[j] = __builtin_amdgcn_rcpf(1.0f + __builtin_amdgcn_exp2f(acc[ai][bj][m][0][j] * nr)); v1[j] = __builtin_amdgcn_rcpf(1.0f + __builtin_amdgcn_exp2f(acc[ai][bj][m][1][j] * nr)); } }
                    else { v0 = acc[ai][bj][m][0] * rs; v1 = acc[ai][bj][m][1] * rs; }
                    u32x4 w; w.x = cvt_pk_bf16(v0[0], v0[1]); w.y = cvt_pk_bf16(v0[2], v0[3]); w.z = cvt_pk_bf16(v1[0], v1[1]); w.w = cvt_pk_bf16(v1[2], v1[3]);
                    *(u32x4*)(rowp + bj * HALF) = w; }
                asm volatile("" ::: "memory"); }
    }
};
struct EpiResidual {
    static constexpr bool PERM = true, AFTER_DRAIN = false;
    bf16_t* HB; float* ssq_out;
    __device__ __forceinline__ void operator()(const f32x4 (&acc)[2][2][4][2], const Unit& u, int wr, int wc, int fr, int fq) const {
        const int row0 = u.pm * BM + wr * 64 + fr, col0 = u.pn * BM + wc * 32 + 8 * fq;
#pragma unroll
        for (int ai = 0; ai < 2; ++ai)
#pragma unroll
            for (int m = 0; m < 4; ++m) { const int row = row0 + ai * HALF + m * 16; bf16_t* bp = HB + (size_t)row * 2048 + col0; float s = 0.f;
                u32x4 hv[2];
#pragma unroll
                for (int bj = 0; bj < 2; ++bj) hv[bj] = *(const u32x4*)(bp + bj * HALF);
#pragma unroll
                for (int bj = 0; bj < 2; ++bj) { const f32x4 a0 = acc[ai][bj][m][0], a1 = acc[ai][bj][m][1]; const u32x4 x = hv[bj];
                    const float h0 = bf_lo(x.x) + a0[0], h1 = bf_hi(x.x) + a0[1], h2 = bf_lo(x.y) + a0[2], h3 = bf_hi(x.y) + a0[3], h4 = bf_lo(x.z) + a1[0], h5 = bf_hi(x.z) + a1[1], h6 = bf_lo(x.w) + a1[2], h7 = bf_hi(x.w) + a1[3];
                    s += (h0 * h0 + h1 * h1) + (h2 * h2 + h3 * h3) + (h4 * h4 + h5 * h5) + (h6 * h6 + h7 * h7);
                    u32x4 w; w.x = cvt_pk_bf16(h0, h1); w.y = cvt_pk_bf16(h2, h3); w.z = cvt_pk_bf16(h4, h5); w.w = cvt_pk_bf16(h6, h7); *(u32x4*)(bp + bj * HALF) = w; }
                { const int ln = fr + 16 * fq; s += shx(s, 16, ln); s += shx(s, 32, ln); }
                if (fq == 0) ssq_out[(size_t)row * 32 + u.pn * 4 + wc] = s;
                asm volatile("" ::: "memory"); }
    }
};
struct EpiSwiglu {
    static constexpr bool PERM = true, AFTER_DRAIN = false;
    bf16_t* ACT; const float* ssq;
    __device__ __forceinline__ void operator()(const f32x4 (&acc)[2][2][4][2], const Unit& u, int wr, int wc, int fr, int fq) const {
        const int row0 = u.pm * BM + wr * 64 + fr, ch0 = u.pn * 128 + wc * 32 + 8 * fq;
#pragma unroll
        for (int ai = 0; ai < 2; ++ai)
#pragma unroll
            for (int m = 0; m < 4; ++m) { const int row = row0 + ai * HALF + m * 16; const float rs = row_rstd(ssq, row, fr, fq), rs2 = rs * rs, nrl = -1.4426950408889634f * rs;
                float o[8];
#pragma unroll
                for (int n = 0; n < 2; ++n) { const f32x4 g = acc[ai][0][m][n], gu = g * acc[ai][1][m][n] * rs2;
#pragma unroll
                    for (int j = 0; j < 4; ++j) o[4 * n + j] = gu[j] * __builtin_amdgcn_rcpf(1.0f + __builtin_amdgcn_exp2f(g[j] * nrl)); }
                u32x4 w; w.x = cvt_pk_bf16(o[0], o[1]); w.y = cvt_pk_bf16(o[2], o[3]); w.z = cvt_pk_bf16(o[4], o[5]); w.w = cvt_pk_bf16(o[6], o[7]);
                *(u32x4*)(ACT + (size_t)row * 5632 + ch0) = w;
                asm volatile("" ::: "memory"); }
    }
};
struct EpiRgIn {
    static constexpr bool PERM = true, AFTER_DRAIN = false;
    bf16_t *GG, *REC; const float* ssq;
    __device__ __forceinline__ void operator()(const f32x4 (&acc)[2][2][4][2], const Unit& u, int wr, int wc, int fr, int fq) const {
        const int row0 = u.pm * BM + wr * 64 + fr; const bool gate = u.pn < 8;
        bf16_t* base = gate ? GG : REC; const int col0 = (gate ? u.pn : u.pn - 8) * BM + wc * 32 + 8 * fq;
#pragma unroll
        for (int ai = 0; ai < 2; ++ai)
#pragma unroll
            for (int m = 0; m < 4; ++m) { const int row = row0 + ai * HALF + m * 16; const float rs = row_rstd(ssq, row, fr, fq);
                bf16_t* rowp = base + (size_t)row * 2048 + col0;
#pragma unroll
                for (int bj = 0; bj < 2; ++bj) { f32x4 v0 = acc[ai][bj][m][0] * rs, v1 = acc[ai][bj][m][1] * rs;
                    if (gate) {
#pragma unroll
                        for (int j = 0; j < 4; ++j) { v0[j] = gelu_tanh(v0[j]); v1[j] = gelu_tanh(v1[j]); } }
                    u32x4 w; w.x = cvt_pk_bf16(v0[0], v0[1]); w.y = cvt_pk_bf16(v0[2], v0[3]); w.z = cvt_pk_bf16(v1[0], v1[1]); w.w = cvt_pk_bf16(v1[2], v1[3]);
                    *(u32x4*)(rowp + bj * HALF) = w; }
                asm volatile("" ::: "memory"); }
    }
};
struct EpiRgGates {
    static constexpr bool PERM = true, AFTER_DRAIN = false;
    const bf16_t* XC; bf16_t *LA, *U; const float *gate_b, *a_param;
    __device__ __forceinline__ void operator()(const f32x4 (&acc)[2][2][4][2], const Unit& u, int wr, int wc, int fr, int fq) const {
        const int row0 = u.pm * BM + wr * 64 + fr, blk = u.pn >> 1, lh = u.pn & 1;
        const int chb = 128 * lh + 32 * wc + 8 * fq, chg = blk * 256 + chb;
        f32x4 br[2], bi[2], ls[2];
        constexpr float NL2E = -1.4426950408889634f;
#pragma unroll
        for (int n = 0; n < 2; ++n) { br[n] = *(const f32x4*)(gate_b + blk * 512 + chb + 4 * n) * NL2E; bi[n] = *(const f32x4*)(gate_b + blk * 512 + 256 + chb + 4 * n) * NL2E;
            const f32x4 ap = *(const f32x4*)(a_param + chg + 4 * n);
#pragma unroll
            for (int j = 0; j < 4; ++j) ls[n][j] = 8.0f * logsigmoidf_(ap[j]); }
#pragma unroll
        for (int ai = 0; ai < 2; ++ai)
#pragma unroll
            for (int m = 0; m < 4; ++m) { const size_t rowoff = (size_t)(row0 + ai * HALF + m * 16) * 2048 + chg;
                const u32x4 xw = *(const u32x4*)(XC + rowoff);
                const float xc[8] = {bf_lo(xw.x), bf_hi(xw.x), bf_lo(xw.y), bf_hi(xw.y), bf_lo(xw.z), bf_hi(xw.z), bf_lo(xw.w), bf_hi(xw.w)}; float la[8], uu[8];
#pragma unroll
                for (int n = 0; n < 2; ++n)
#pragma unroll
                    for (int j = 0; j < 4; ++j) { const float r = __builtin_amdgcn_rcpf(1.0f + __builtin_amdgcn_exp2f(__builtin_fmaf(acc[ai][0][m][n][j], NL2E, br[n][j])));
                        const float ig = __builtin_amdgcn_rcpf(1.0f + __builtin_amdgcn_exp2f(__builtin_fmaf(acc[ai][1][m][n][j], NL2E, bi[n][j])));
                        const float l = r * ls[n][j]; la[4 * n + j] = l;
                        uu[4 * n + j] = __builtin_amdgcn_sqrtf(1.0f - __builtin_amdgcn_exp2f(l * 2.8853900817779268f)) * ig * xc[4 * n + j]; }
                u32x4 w; w.x = cvt_pk_bf16(la[0], la[1]); w.y = cvt_pk_bf16(la[2], la[3]); w.z = cvt_pk_bf16(la[4], la[5]); w.w = cvt_pk_bf16(la[6], la[7]); *(u32x4*)(LA + rowoff) = w;
                w.x = cvt_pk_bf16(uu[0], uu[1]); w.y = cvt_pk_bf16(uu[2], uu[3]); w.z = cvt_pk_bf16(uu[4], uu[5]); w.w = cvt_pk_bf16(uu[6], uu[7]); *(u32x4*)(U + rowoff) = w;
                asm volatile("" ::: "memory"); }
    }
};
struct EpiNull { static constexpr bool PERM = true, AFTER_DRAIN = false; float* sink;
    __device__ __forceinline__ void operator()(const f32x4 (&acc)[2][2][4][2], const Unit& u, int wr, int wc, int fr, int fq) const {
        float s = 0.f;
#pragma unroll
        for (int ai = 0; ai < 2; ++ai)
#pragma unroll
            for (int bj = 0; bj < 2; ++bj)
#pragma unroll
                for (int m = 0; m < 4; ++m)
#pragma unroll
                    for (int n = 0; n < 2; ++n) s += acc[ai][bj][m][n][0] + acc[ai][bj][m][n][1] + acc[ai][bj][m][n][2] + acc[ai][bj][m][n][3];
        if (s == 1.2345e-30f) sink[0] = s; } };
struct GateOrder : StaticOrder {
    __device__ bool next(int i, Unit& u) const { if (!StaticOrder::next(i, u)) return false; u.aoff = (u.pn >> 1) * 512; return true; }
};
}

#define LAS __attribute__((address_space(3)))
using pg8::bf16_t; using pg8::bf16x8; using pg8::f32x4; using pg8::u32x4; using pg8::u32x2; using pg8::cvt_pk_bf16; using pg8::bf_lo; using pg8::bf_hi; using pg8::RMS_EPS; using pg8::shx; using pg8::shi; using pg8::logsigmoidf_;
typedef short s16x4 __attribute__((ext_vector_type(4)));
typedef float f32x2_ __attribute__((ext_vector_type(2)));
constexpr int M_ = 16384, D_ = 2048, S_ = 8192, DFF_ = 5632, NTHR = 512;
constexpr size_t MiB = 1u << 20;
constexpr size_t WS_SSQ = 552 * MiB, SSQ_STAGE = (size_t)16384 * 32;
constexpr size_t WS_IG = 1 * MiB, WS_LF = 1 * MiB + 512 * 1024;
constexpr size_t WS_NL = 2 * MiB;
constexpr size_t WS_ML = 2 * MiB + 256 * 1024, WS_BT = WS_ML + 4096, WS_MS = WS_BT + 4096;
constexpr size_t WS_SP = 3 * MiB, WS_SH = 4 * MiB; constexpr size_t WS_BAR = 5 * MiB, BAR_BYTES = 16384;
constexpr int LDS_MISC = 131072;
constexpr size_t WS_WM_IN = 8 * MiB, WS_WM_OUT = 32 * MiB, WS_WF_IN0 = 40 * MiB, WS_WF_IN1 = 84 * MiB, WS_WF_OUT0 = 128 * MiB, WS_WF_OUT1 = 150 * MiB,
                 WS_WR_IN = 172 * MiB, WS_WG = 188 * MiB, WS_WR_OUT = 190 * MiB;
constexpr size_t WS_HB = 200 * MiB;
constexpr size_t WS_R0 = 264 * MiB, WS_R1 = 328 * MiB, WS_R2 = 392 * MiB, WS_R3 = 456 * MiB;
constexpr size_t WS_CL = 520 * MiB, WS_END = 562 * MiB;
constexpr int LDS_BYTES = 147456;

struct Args { const float* in[17]; float* out; unsigned char* ws; };
typedef const __attribute__((address_space(4))) Args& KA;
enum { I_X = 0, I_NMIX, I_NFFN, I_NFIN, I_MWIN, I_MBIF, I_MHN, I_MWOUT, I_RWIN, I_RCW, I_RCB, I_RGW, I_RGB, I_RAP, I_RWOUT, I_FWIN, I_FWOUT };

__device__ __forceinline__ int launder_v(int v) { asm volatile("" : "+v"(v)); return v; }
__device__ __forceinline__ int launder_s(int v) { asm volatile("" : "+s"(v)); return v; }
__device__ __forceinline__ void lds_wait() { asm volatile("s_waitcnt lgkmcnt(0)" ::: "memory"); }
__device__ __forceinline__ float bf2f(unsigned short v) { return __uint_as_float((unsigned)v << 16); }

#define XB_TMO      128
#define XB_XCNT(j)  (256  + 64 * (j))
#define XB_XSUB(j)  (1280 + 64 * (j))
#define XB_XGEN(j)  (2304 + 64 * (j))
#define XB_TOP      3328
#define XB_TOPGEN   3392
#define XCD_BAR_WORDS 3456
#define XB_SPIN_CAP (1u << 18)

__device__ __forceinline__ unsigned xb_ld(unsigned* p)              { return __hip_atomic_load(p, __ATOMIC_RELAXED, __HIP_MEMORY_SCOPE_AGENT); }
__device__ __forceinline__ unsigned xb_add(unsigned* p, unsigned v) { return __hip_atomic_fetch_add(p, v, __ATOMIC_RELAXED, __HIP_MEMORY_SCOPE_AGENT); }
__device__ __forceinline__ unsigned xb_xcc_id() { return (unsigned)__builtin_amdgcn_s_getreg((3 << 11) | 20) & 0xFu; }
#define XB_SPIN(cond, bar) do { unsigned _sp = 0; while (cond) { __builtin_amdgcn_s_sleep(1); \
    if ((++_sp & 255u) == 0u) { if (xb_ld(&(bar)[XB_TMO])) break; if (_sp > XB_SPIN_CAP) { atomicAdd(&(bar)[XB_TMO], 1u); break; } } } } while (0)

struct XcdBarrier {
    unsigned* bar; unsigned x;
    volatile LAS unsigned* st;
};

__device__ __forceinline__ XcdBarrier xcd_barrier_post(unsigned* bar, volatile LAS unsigned* st) {
    XcdBarrier b; b.bar = bar; b.x = xb_xcc_id(); b.st = st;
    if (threadIdx.x == 0) (void)xb_add(&bar[XB_XCNT(b.x)], 1u);
    return b;
}
__device__ __forceinline__ void xcd_barrier_complete(unsigned* bar, unsigned x, unsigned& nloc, unsigned& nx) {
    const unsigned G = gridDim.x * gridDim.y * gridDim.z;
    unsigned sum, cnt, mine, sp = 0u;
    for (;;) {
        sum = 0u; cnt = 0u; mine = 0u;
#pragma unroll
        for (unsigned j = 0; j < 16; ++j) { const unsigned c = xb_ld(&bar[XB_XCNT(j)]); sum += c; cnt += (c > 0u) ? 1u : 0u; mine = (j == x) ? c : mine; }
        if (sum == G) break;
        __builtin_amdgcn_s_sleep(1);
        if ((++sp & 255u) == 0u) { if (xb_ld(&bar[XB_TMO])) break; if (sp > XB_SPIN_CAP) { atomicAdd(&bar[XB_TMO], 1u); break; } }
    }
    nloc = mine > 0u ? mine : 1u; nx = cnt > 0u ? cnt : 1u;
}

__device__ __forceinline__ void xcd_barrier(const XcdBarrier& b) {
    asm volatile("s_waitcnt vmcnt(0)" ::: "memory");
    __syncthreads();
    if (threadIdx.x == 0) {
        unsigned* bar = b.bar;
        __builtin_amdgcn_s_waitcnt(0);
        unsigned nloc = b.st[0], nx = b.st[1];
        if (nloc == 0u) { xcd_barrier_complete(bar, b.x, nloc, nx); b.st[0] = nloc; b.st[1] = nx; }
        const unsigned old = xb_add(&bar[XB_XSUB(b.x)], 1u);
        const unsigned gen = old / nloc;
        if (old + 1u == (gen + 1u) * nloc) {
            __builtin_amdgcn_fence(__ATOMIC_RELEASE, "agent");
            asm volatile("s_waitcnt vmcnt(0)" ::: "memory");
            const unsigned og = xb_add(&bar[XB_TOP], 1u);
            const unsigned tg = og / nx;
            if (og + 1u == (tg + 1u) * nx) xb_add(&bar[XB_TOPGEN], 1u);
            else XB_SPIN(xb_ld(&bar[XB_TOPGEN]) == tg, bar);
            __builtin_amdgcn_fence(__ATOMIC_ACQUIRE, "agent");
            xb_add(&bar[XB_XGEN(b.x)], 1u);
            asm volatile("s_waitcnt vmcnt(0)" ::: "memory");
        } else {
            XB_SPIN(xb_ld(&bar[XB_XGEN(b.x)]) == gen, bar);
            __builtin_amdgcn_fence(__ATOMIC_ACQUIRE, "agent");
            asm volatile("s_waitcnt vmcnt(0)" ::: "memory");
        }
    }
    __syncthreads();
}

struct CvtJob { const float* W; const float* gk; bf16_t* WT; int K, ldn, N, mode, item; };
struct CvtRegs { float vv[32]; f32x4 g0, g1; };
__device__ __forceinline__ void cvt_load(const CvtJob& j, CvtRegs& R, int lane) {
    const int nblk = j.N >> 5, kb = j.item / nblk, nb = j.item - kb * nblk, k0 = kb * 64, n0 = nb * 32;
    const float* p = j.W + (size_t)(k0 + (lane >> 5)) * j.ldn + n0 + (lane & 31);
#pragma unroll
    for (int i = 0; i < 32; ++i) R.vv[i] = p[(size_t)(2 * i) * j.ldn];
    if (j.gk) { R.g0 = *(const f32x4*)(j.gk + k0 + 8 * (lane & 7)); R.g1 = *(const f32x4*)(j.gk + k0 + 8 * (lane & 7) + 4); }
    else { R.g0 = (f32x4){1.f, 1.f, 1.f, 1.f}; R.g1 = R.g0; }
}
__device__ __forceinline__ void cvt_store(const CvtJob& j, CvtRegs& R, LAS float* scr, int lane) {
    const int nblk = j.N >> 5, kb = j.item / nblk, nb = j.item - kb * nblk, k0 = kb * 64, n0 = nb * 32, mode = j.mode, K = j.K;
#pragma unroll
    for (int i = 0; i < 32; ++i) scr[(2 * i + (lane >> 5)) * 33 + (lane & 31)] = R.vv[i];
    lds_wait();
    const int c = lane & 7;
#pragma unroll
    for (int jj = 0; jj < 4; ++jj) { const int n = (lane >> 3) + 8 * jj, col = n0 + n; const LAS float* sp = scr + (8 * c) * 33 + n;
        float cs = 1.f; int dest = col;
        if (mode == 1) { cs = (col >= 1024 && col < 2048) ? 0.08838834764831845f : 1.f; }
        else if (mode == 2) { const int nn = col >= 5632 ? 1 : 0, ch = col - nn * 5632; dest = 256 * (ch >> 7) + 128 * nn + (ch & 127); }
        else if (mode == 3) { const int nn = col >= 256 ? 1 : 0, ch = col - nn * 256; dest = 256 * (ch >> 7) + 128 * nn + (ch & 127); }
        const f32x4 g0 = R.g0 * cs, g1 = R.g1 * cs;
        u32x4 o; o.x = cvt_pk_bf16(sp[0 * 33] * g0[0], sp[1 * 33] * g0[1]); o.y = cvt_pk_bf16(sp[2 * 33] * g0[2], sp[3 * 33] * g0[3]); o.z = cvt_pk_bf16(sp[4 * 33] * g1[0], sp[5 * 33] * g1[1]); o.w = cvt_pk_bf16(sp[6 * 33] * g1[2], sp[7 * 33] * g1[3]);
        *(u32x4*)(j.WT + (size_t)dest * K + k0 + 8 * c) = o; }
    lds_wait();
}
__device__ __forceinline__ void x_half(KA a, int grp, int half, int lane, f32x4& acc, float& ss) {
    const float* __restrict__ x = a.in[I_X]; const float* __restrict__ W = a.in[I_MWIN]; const float* __restrict__ gmix = a.in[I_NMIX];
    bf16_t* XB = (bf16_t*)(a.ws + WS_HB);
    const int row0 = grp * 16, r = lane & 15, quad = lane >> 4, kbase = half * 1024;
    const float* xr = x + (size_t)(row0 + r) * D_ + quad * 8 + kbase; bf16_t* br = XB + (size_t)(row0 + r) * D_ + quad * 8 + kbase;
    const float* wp = W + (size_t)(kbase + quad * 8) * 6160 + 6144 + r; const float* gp = gmix + kbase + quad * 8;
    acc = (f32x4){0.f, 0.f, 0.f, 0.f}; ss = 0.f;
#pragma unroll 4
    for (int k0 = 0; k0 < 1024; k0 += 32) {
        const f32x4 a0 = *(const f32x4*)(xr + k0), a1 = *(const f32x4*)(xr + k0 + 4);
        ss += (a0[0] * a0[0] + a0[1] * a0[1]) + (a0[2] * a0[2] + a0[3] * a0[3]) + (a1[0] * a1[0] + a1[1] * a1[1]) + (a1[2] * a1[2] + a1[3] * a1[3]);
        u32x4 aw; aw.x = cvt_pk_bf16(a0[0], a0[1]); aw.y = cvt_pk_bf16(a0[2], a0[3]); aw.z = cvt_pk_bf16(a1[0], a1[1]); aw.w = cvt_pk_bf16(a1[2], a1[3]);
        *(u32x4*)(br + k0) = aw;
        const f32x4 g0 = *(const f32x4*)(gp + k0), g1 = *(const f32x4*)(gp + k0 + 4);
        const float* w = wp + (size_t)k0 * 6160;
        u32x4 bw; bw.x = cvt_pk_bf16(w[0] * g0[0], w[6160] * g0[1]); bw.y = cvt_pk_bf16(w[2 * 6160] * g0[2], w[3 * 6160] * g0[3]);
        bw.z = cvt_pk_bf16(w[4 * 6160] * g1[0], w[5 * 6160] * g1[1]); bw.w = cvt_pk_bf16(w[6 * 6160] * g1[2], w[7 * 6160] * g1[3]);
        acc = __builtin_amdgcn_mfma_f32_16x16x32_bf16(__builtin_bit_cast(bf16x8, aw), __builtin_bit_cast(bf16x8, bw), acc, 0, 0, 0);
    }
}
__device__ __forceinline__ void x_finish(KA a, int grp, int lane, f32x4 acc, float ss) {
    float* ssq0 = (float*)(a.ws + WS_SSQ);
    const int row0 = grp * 16, r = lane & 15, quad = lane >> 4;
    ss += shx(ss, 16, lane); ss += shx(ss, 32, lane);
    { const f32x4 z = {0.f, 0.f, 0.f, 0.f}; f32x4 first = z; if (quad == 0) first[0] = ss; float* sp = ssq0 + (size_t)(row0 + r) * 32 + quad * 8; *(f32x4*)sp = first; *(f32x4*)(sp + 4) = z; }
    const int n = r; const float bias = a.in[I_MBIF][n];
    float* IG = (float*)(a.ws + WS_IG); float* LF = (float*)(a.ws + WS_LF);
#pragma unroll
    for (int rr = 0; rr < 4; ++rr) { const int row = 4 * quad + rr; const float srow = shi(ss, row); const float rs = rsqrtf(srow * (1.0f / 2048.0f) + RMS_EPS);
        const float pre = acc[rr] * rs + bias; const int grow = row0 + row, b = grow >> 13, t = grow & 8191, h = n & 7; const size_t idx = (size_t)(b * 8 + h) * S_ + t;
        if (n < 8) IG[idx] = pre; else LF[idx] = logsigmoidf_(pre); }
}
__device__ __forceinline__ bool cvt_decode(KA a, int r, CvtJob& j) {
    constexpr int I0 = 32 * 192, I1 = 32 * 64, I2 = 32 * 352, I4 = 88 * 64, I6 = 32 * 128, I7 = 8 * 64, I8 = 32 * 64;
    j.gk = nullptr; j.mode = 0; j.K = 2048; j.ldn = 2048; j.N = 2048;
    if (r < I0) { j.W = a.in[I_MWIN]; j.ldn = 6160; j.N = 6144; j.WT = (bf16_t*)(a.ws + WS_WM_IN); j.mode = 1; j.gk = a.in[I_NMIX]; j.item = r; return true; } r -= I0;
    if (r < I1) { j.W = a.in[I_MWOUT]; j.WT = (bf16_t*)(a.ws + WS_WM_OUT); j.item = r; return true; } r -= I1;
    if (r < I2) { j.W = a.in[I_FWIN]; j.ldn = 11264; j.N = 11264; j.WT = (bf16_t*)(a.ws + WS_WF_IN0); j.mode = 2; j.gk = a.in[I_NFFN]; j.item = r; return true; } r -= I2;
    if (r < I2) { j.W = a.in[I_FWIN] + (size_t)2048 * 11264; j.ldn = 11264; j.N = 11264; j.WT = (bf16_t*)(a.ws + WS_WF_IN1); j.mode = 2; j.gk = a.in[I_NFFN] + 2048; j.item = r; return true; } r -= I2;
    if (r < I4) { j.W = a.in[I_FWOUT]; j.K = 5632; j.WT = (bf16_t*)(a.ws + WS_WF_OUT0); j.item = r; return true; } r -= I4;
    if (r < I4) { j.W = a.in[I_FWOUT] + (size_t)5632 * 2048; j.K = 5632; j.WT = (bf16_t*)(a.ws + WS_WF_OUT1); j.item = r; return true; } r -= I4;
    if (r < I6) { j.W = a.in[I_RWIN]; j.ldn = 4096; j.N = 4096; j.WT = (bf16_t*)(a.ws + WS_WR_IN); j.gk = a.in[I_NMIX] + 2048; j.item = r; return true; } r -= I6;
    if (r < I7) { const int blk = r >> 6; j.W = a.in[I_RGW] + (size_t)blk * 256 * 512; j.K = 256; j.ldn = 512; j.N = 512; j.WT = (bf16_t*)(a.ws + WS_WG) + (size_t)blk * 512 * 256; j.mode = 3; j.item = r & 63; return true; } r -= I7;
    if (r < I8) { j.W = a.in[I_RWOUT]; j.WT = (bf16_t*)(a.ws + WS_WR_OUT); j.item = r; return true; }
    return false;
}
__device__ __forceinline__ void prologue(KA a, LAS unsigned char* lds, int bid, int G, int lane, int wave) {
    LAS float* scr = (LAS float*)(lds + wave * 16384);
    for (int g0 = bid * 4; g0 < M_ / 16; g0 += G * 4) {
        const int grp = g0 + (wave & 3); f32x4 acc; float ss;
        x_half(a, grp, wave >> 2, lane, acc, ss);
        LAS float* xs = (LAS float*)(lds + (wave & 3) * 16384 + 12288) + lane * 5;
        if (wave >= 4) { xs[0] = acc[0]; xs[1] = acc[1]; xs[2] = acc[2]; xs[3] = acc[3]; xs[4] = ss; }
        __syncthreads();
        if (wave < 4) { acc[0] += xs[0]; acc[1] += xs[1]; acc[2] += xs[2]; acc[3] += xs[3]; ss += xs[4]; x_finish(a, grp, lane, acc, ss); }
        __syncthreads();
    }
    const int gw = wave * G + bid, NGW = G * 8;
    CvtJob j0, j1; CvtRegs r0, r1;
    int it = gw; bool ok0 = cvt_decode(a, it, j0), ok1;
    if (ok0) cvt_load(j0, r0, lane);
    while (ok0) {
        ok1 = cvt_decode(a, it + NGW, j1); if (ok1) cvt_load(j1, r1, lane);
        cvt_store(j0, r0, scr, lane);
        if (!ok1) break;
        it += 2 * NGW; ok0 = cvt_decode(a, it, j0); if (ok0) cvt_load(j0, r0, lane);
        cvt_store(j1, r1, scr, lane);
    }
}

__device__ __forceinline__ s16x4 tr16(const LAS short* p) { return __builtin_amdgcn_ds_read_tr16_b64_v4i16((LAS s16x4*)p); }
__device__ __forceinline__ bf16x8 tr_frag(const LAS short* T, int pitch, int krow0, int col0, int lane) {
    const int g = lane >> 4, q = (lane & 15) >> 2, p = lane & 3;
    const LAS short* a0 = T + (krow0 + 8 * g + q) * pitch + col0 + 4 * p;
    const s16x4 lo = tr16(a0), hi = tr16(a0 + 4 * pitch);
    bf16x8 r; r[0] = lo[0]; r[1] = lo[1]; r[2] = lo[2]; r[3] = lo[3]; r[4] = hi[0]; r[5] = hi[1]; r[6] = hi[2]; r[7] = hi[3]; return r;
}
constexpr int PQ = 136, PV = 264, PP = 72;
constexpr int L_Q = 0, L_K = 17408, L_KW = 34816, L_V = 52224, L_P = 86016, L_F = 95232;
constexpr int F_B = 0, F_PM = 64, F_SI = 128, F_HD = 192, F_N = 256, F_SSQ = 384;

struct ChunkGates { float a, pm, b, wk, decay, m_new, b_last; };
struct GateScan { float a, b, cm, b_last, cm_last; };
__device__ __forceinline__ GateScan gate_scan(float ig, float lf, int lane) {
    GateScan g; float b = lf;
#pragma unroll
    for (int o = 1; o < 64; o <<= 1) { const float t = shi(b, lane >= o ? lane - o : lane); if (lane >= o) b += t; }
    const float av = ig - b; float cm = av;
#pragma unroll
    for (int o = 1; o < 64; o <<= 1) { const float t = shi(cm, lane >= o ? lane - o : lane); if (lane >= o) cm = fmaxf(cm, t); }
    g.a = av; g.b = b; g.cm = cm; g.b_last = shi(b, 63); g.cm_last = shi(cm, 63); return g;
}
__device__ __forceinline__ ChunkGates gate_finish(const GateScan& s, float m) {
    ChunkGates g; g.a = s.a; g.b = s.b; g.pm = fmaxf(m, s.cm); g.b_last = s.b_last;
    const float pml = fmaxf(m, s.cm_last);
    g.wk = __expf(s.a - pml); g.decay = __expf(m - pml); g.m_new = s.b_last + pml; return g;
}
__device__ __forceinline__ u32x4 scale_bf16x8(u32x4 v, float w) {
    u32x4 o; o.x = cvt_pk_bf16(bf_lo(v.x) * w, bf_hi(v.x) * w); o.y = cvt_pk_bf16(bf_lo(v.y) * w, bf_hi(v.y) * w); o.z = cvt_pk_bf16(bf_lo(v.z) * w, bf_hi(v.z) * w); o.w = cvt_pk_bf16(bf_lo(v.w) * w, bf_hi(v.w) * w); return o;
}
__device__ __forceinline__ void state_update(f32x4 (&C)[8][2], const bf16x8 (&Vf)[2][2], const LAS short* KWs, float decay, int lane) {
#pragma unroll
    for (int db = 0; db < 8; ++db) {
#pragma unroll
        for (int vb = 0; vb < 2; ++vb) C[db][vb] = C[db][vb] * decay;
#pragma unroll
        for (int ks = 0; ks < 2; ++ks) { const bf16x8 A = tr_frag(KWs, PQ, 32 * ks, 16 * db, lane);
#pragma unroll
            for (int vb = 0; vb < 2; ++vb) C[db][vb] = __builtin_amdgcn_mfma_f32_16x16x32_bf16(A, Vf[vb][ks], C[db][vb], 0, 0, 0); } }
}
__device__ __forceinline__ void mlstm_local(KA a, LAS unsigned char* lds, int tid, int lane, int wave) {
    LAS short* KWs = (LAS short*)(lds + L_KW); LAS short* Vs = (LAS short*)(lds + L_V); LAS float* fv = (LAS float*)(lds + L_F);
    const bf16_t* Kg = (const bf16_t*)(a.ws + WS_R0 + 32 * MiB); const bf16_t* Vg = (const bf16_t*)(a.ws + WS_R1);
    const float* IG = (const float*)(a.ws + WS_IG); const float* LF = (const float*)(a.ws + WS_LF);
    for (int item = blockIdx.x; item < 256; item += gridDim.x) {
        const int bh = item >> 4, sc = item & 15, b = bh >> 3, h = bh & 7;
        f32x4 C[8][2];
#pragma unroll
        for (int db = 0; db < 8; ++db) { C[db][0] = (f32x4){0.f, 0.f, 0.f, 0.f}; C[db][1] = (f32x4){0.f, 0.f, 0.f, 0.f}; }
        float m = -1e30f, btot = 0.f;
        __syncthreads();
        if (tid < 128) fv[F_N + tid] = 0.f;
        u32x4 kreg[2], vreg[4]; float igr, lfr;
        { const size_t row0 = (size_t)b * S_ + sc * 512;
#pragma unroll
          for (int i = 0; i < 2; ++i) { const int p = tid + 512 * i, r = p >> 4, pc = p & 15; kreg[i] = *(const u32x4*)(Kg + (row0 + r) * 1024 + h * 128 + pc * 8); }
#pragma unroll
          for (int i = 0; i < 4; ++i) { const int p = tid + 512 * i, r = p >> 5, pc = p & 31; vreg[i] = *(const u32x4*)(Vg + (row0 + r) * 2048 + h * 256 + pc * 8); }
          igr = IG[(size_t)bh * S_ + sc * 512 + lane]; lfr = LF[(size_t)bh * S_ + sc * 512 + lane]; }
        GateScan gs = gate_scan(igr, lfr, lane);
        for (int ch = 0; ch < 8; ++ch) {
            const ChunkGates g = gate_finish(gs, m);
            __syncthreads();
#pragma unroll
            for (int i = 0; i < 2; ++i) { const int p = tid + 512 * i, r = p >> 4, pc = p & 15; *(LAS u32x4*)(KWs + r * PQ + pc * 8) = scale_bf16x8(kreg[i], shi(g.wk, r)); }
#pragma unroll
            for (int i = 0; i < 4; ++i) { const int p = tid + 512 * i, r = p >> 5, pc = p & 31; *(LAS u32x4*)(Vs + r * PV + pc * 8) = vreg[i]; }
            if (ch < 7) { const int t1 = sc * 512 + (ch + 1) * 64; const size_t row1 = (size_t)b * S_ + t1;
#pragma unroll
                for (int i = 0; i < 2; ++i) { const int p = tid + 512 * i, r = p >> 4, pc = p & 15; kreg[i] = *(const u32x4*)(Kg + (row1 + r) * 1024 + h * 128 + pc * 8); }
#pragma unroll
                for (int i = 0; i < 4; ++i) { const int p = tid + 512 * i, r = p >> 5, pc = p & 31; vreg[i] = *(const u32x4*)(Vg + (row1 + r) * 2048 + h * 256 + pc * 8); }
                igr = IG[(size_t)bh * S_ + t1 + lane]; lfr = LF[(size_t)bh * S_ + t1 + lane]; }
            __syncthreads();
            bf16x8 Vf[2][2];
#pragma unroll
            for (int vb = 0; vb < 2; ++vb)
#pragma unroll
                for (int ks = 0; ks < 2; ++ks) Vf[vb][ks] = tr_frag(Vs, PV, 32 * ks, 32 * wave + 16 * vb, lane);
            state_update(C, Vf, KWs, g.decay, lane);
            if (tid < 128) { float s = 0.f;
#pragma unroll 8
                for (int s_ = 0; s_ < 64; ++s_) s += bf2f((unsigned short)KWs[s_ * PQ + tid]);
                fv[F_N + tid] = g.decay * fv[F_N + tid] + s; }
            m = g.m_new; btot += g.b_last;
            if (ch < 7) gs = gate_scan(igr, lfr, lane);
        }
        float* CL = (float*)(a.ws + WS_CL) + (size_t)item * 32768;
#pragma unroll
        for (int db = 0; db < 8; ++db)
#pragma unroll
            for (int vb = 0; vb < 2; ++vb)
#pragma unroll
                for (int r = 0; r < 4; ++r) CL[((db * 2 + vb) * 4 + r) * 512 + tid] = C[db][vb][r];
        if (tid < 128) ((float*)(a.ws + WS_NL))[item * 128 + tid] = fv[F_N + tid];
        if (tid == 0) { ((float*)(a.ws + WS_ML))[item] = m; ((float*)(a.ws + WS_BT))[item] = btot; }
    }
}
__device__ __forceinline__ void mlstm_scan(KA a, LAS unsigned char* lds, int tid, int gtid, int nthr) {
    float* CL = (float*)(a.ws + WS_CL); float* NL = (float*)(a.ws + WS_NL);
    const float* ML = (const float*)(a.ws + WS_ML); const float* BT = (const float*)(a.ws + WS_BT); float* MS = (float*)(a.ws + WS_MS);
    LAS float* fdc = (LAS float*)lds; LAS float* fdl = fdc + 256;
    __syncthreads();
    if (tid < 16) { float m = 0.f, mlv[16], btv[16];
#pragma unroll
        for (int j = 0; j < 16; ++j) { mlv[j] = ML[tid * 16 + j]; btv[j] = BT[tid * 16 + j]; }
#pragma unroll
        for (int j = 0; j < 16; ++j) { const int item = tid * 16 + j; if (gtid < 16) MS[item] = m;
            const float mn = fmaxf(btv[j] + m, mlv[j]); fdc[item] = __expf(btv[j] + m - mn); fdl[item] = __expf(mlv[j] - mn); m = mn; } }
    __syncthreads();
    for (int e = gtid; e < 16 * 32896; e += nthr) { const int bh = e / 32896, idx = e - bh * 32896; float c = 0.f;
        float* p0 = idx < 32768 ? CL + (size_t)(bh * 16) * 32768 + idx : NL + (bh * 16) * 128 + (idx - 32768); const size_t pstep = idx < 32768 ? 32768 : 128;
        float loc[16];
#pragma unroll
        for (int j = 0; j < 16; ++j) loc[j] = p0[j * pstep];
#pragma unroll
        for (int j = 0; j < 16; ++j) { p0[j * pstep] = c; c = fdc[bh * 16 + j] * c + fdl[bh * 16 + j] * loc[j]; } }
}
__device__ __forceinline__ void mlstm_out(KA a, LAS unsigned char* lds, int tid, int lane_in, int wave) {
    LAS short* Qs = (LAS short*)(lds + L_Q); LAS short* Ks = (LAS short*)(lds + L_K); LAS short* KWs = (LAS short*)(lds + L_KW); LAS short* Vs = (LAS short*)(lds + L_V);
    LAS short* Ps = (LAS short*)(lds + L_P); LAS float* fv = (LAS float*)(lds + L_F);
    const bf16_t* Qg = (const bf16_t*)(a.ws + WS_R0); const bf16_t* Kg = (const bf16_t*)(a.ws + WS_R0 + 32 * MiB); const bf16_t* Vg = (const bf16_t*)(a.ws + WS_R1);
    const bf16_t* Og = (const bf16_t*)(a.ws + WS_R2); bf16_t* HG = (bf16_t*)(a.ws + WS_R3);
    const float* IG = (const float*)(a.ws + WS_IG); const float* LF = (const float*)(a.ws + WS_LF); const float* hnorm = a.in[I_MHN];
    for (int item = blockIdx.x; item < 256; item += gridDim.x) {
        const int bh = item >> 4, sc = item & 15, b = bh >> 3, h = bh & 7;
        f32x4 C[8][2];
        { const float* CL = (const float*)(a.ws + WS_CL) + (size_t)item * 32768;
#pragma unroll
          for (int db = 0; db < 8; ++db)
#pragma unroll
            for (int vb = 0; vb < 2; ++vb)
#pragma unroll
                for (int r = 0; r < 4; ++r) C[db][vb][r] = CL[((db * 2 + vb) * 4 + r) * 512 + tid]; }
        float m = ((const float*)(a.ws + WS_MS))[item];
        __syncthreads();
        if (tid < 128) fv[F_N + tid] = ((const float*)(a.ws + WS_NL))[item * 128 + tid];
        u32x4 qreg[2], kreg[2], vreg[4]; float igr, lfr;
        { const int lane = lane_in, tid = wave * 64 + lane; const size_t row0 = (size_t)b * S_ + sc * 512;
#pragma unroll
          for (int i = 0; i < 2; ++i) { const int p = tid + 512 * i, r = p >> 4, pc = p & 15; qreg[i] = *(const u32x4*)(Qg + (row0 + r) * 1024 + h * 128 + pc * 8); kreg[i] = *(const u32x4*)(Kg + (row0 + r) * 1024 + h * 128 + pc * 8); }
#pragma unroll
          for (int i = 0; i < 4; ++i) { const int p = tid + 512 * i, r = p >> 5, pc = p & 31; vreg[i] = *(const u32x4*)(Vg + (row0 + r) * 2048 + h * 256 + pc * 8); }
          igr = IG[(size_t)bh * S_ + sc * 512 + lane]; lfr = LF[(size_t)bh * S_ + sc * 512 + lane]; }
        GateScan gs = gate_scan(igr, lfr, lane_in);
        f32x4 hnr[2];
#pragma unroll
        for (int vb = 0; vb < 2; ++vb) hnr[vb] = *(const f32x4*)(hnorm + h * 256 + 32 * wave + 16 * vb + 4 * (lane_in >> 4));
        for (int ch = 0; ch < 8; ++ch) {
            const int lane = launder_v(lane_in), tid = wave * 64 + lane, l15 = lane & 15, g4 = lane >> 4;
            const int t0 = sc * 512 + ch * 64; const size_t row0 = (size_t)b * S_ + t0;
            const ChunkGates g = gate_finish(gs, m);
            const float si = __expf(m - g.pm);
            if (wave == 0) { fv[F_B + lane] = g.b; fv[F_PM + lane] = g.pm; fv[F_SI + lane] = si; }
#pragma unroll
            for (int i = 0; i < 2; ++i) { const int p = tid + 512 * i, r = p >> 4, pc = p & 15;
                *(LAS u32x4*)(Qs + r * PQ + pc * 8) = qreg[i]; *(LAS u32x4*)(Ks + r * PQ + pc * 8) = kreg[i]; *(LAS u32x4*)(KWs + r * PQ + pc * 8) = scale_bf16x8(kreg[i], shi(g.wk, r)); }
#pragma unroll
            for (int i = 0; i < 4; ++i) { const int p = tid + 512 * i, r = p >> 5, pc = p & 31; *(LAS u32x4*)(Vs + r * PV + pc * 8) = vreg[i]; }
            if (ch < 7) { const size_t row1 = row0 + 64;
#pragma unroll
                for (int i = 0; i < 2; ++i) { const int p = tid + 512 * i, r = p >> 4, pc = p & 15; qreg[i] = *(const u32x4*)(Qg + (row1 + r) * 1024 + h * 128 + pc * 8); kreg[i] = *(const u32x4*)(Kg + (row1 + r) * 1024 + h * 128 + pc * 8); }
#pragma unroll
                for (int i = 0; i < 4; ++i) { const int p = tid + 512 * i, r = p >> 5, pc = p & 31; vreg[i] = *(const u32x4*)(Vg + (row1 + r) * 2048 + h * 256 + pc * 8); }
                igr = IG[(size_t)bh * S_ + t0 + 64 + lane]; lfr = LF[(size_t)bh * S_ + t0 + 64 + lane]; }
            __syncthreads();
            { const int tb = wave >> 1, t = 16 * tb + l15; const float pm_t = shi(g.pm, t);
#pragma unroll
              for (int xx = 0; xx < 2; ++xx) { const int sb = 2 * (wave & 1) + xx; f32x4 sacc = {0.f, 0.f, 0.f, 0.f};
                if (sb <= tb) {
#pragma unroll
                    for (int ks = 0; ks < 4; ++ks) { const bf16x8 A = *(const LAS bf16x8*)(Ks + (16 * sb + l15) * PQ + 32 * ks + 8 * g4), B = *(const LAS bf16x8*)(Qs + t * PQ + 32 * ks + 8 * g4);
                        sacc = __builtin_amdgcn_mfma_f32_16x16x32_bf16(A, B, sacc, 0, 0, 0); } }
                float p[4];
#pragma unroll
                for (int r = 0; r < 4; ++r) { const int s = 16 * sb + 4 * g4 + r; const float a_s = shi(g.a, s); p[r] = (s <= t) ? sacc[r] * __expf(a_s - pm_t) : 0.f; }
                u32x2 w; w.x = cvt_pk_bf16(p[0], p[1]); w.y = cvt_pk_bf16(p[2], p[3]); *(LAS u32x2*)(Ps + t * PP + 16 * sb + 4 * g4) = w; } }
            __syncthreads();
            f32x4 acc[2][4];
#pragma unroll
            for (int vb = 0; vb < 2; ++vb)
#pragma unroll
                for (int tb = 0; tb < 4; ++tb) acc[vb][tb] = (f32x4){0.f, 0.f, 0.f, 0.f};
#pragma unroll
            for (int ks = 0; ks < 4; ++ks) { bf16x8 Cf[2];
#pragma unroll
                for (int vb = 0; vb < 2; ++vb) { u32x4 w; const f32x4 c0 = C[2 * ks][vb], c1 = C[2 * ks + 1][vb];
                    w.x = cvt_pk_bf16(c0[0], c0[1]); w.y = cvt_pk_bf16(c0[2], c0[3]); w.z = cvt_pk_bf16(c1[0], c1[1]); w.w = cvt_pk_bf16(c1[2], c1[3]); Cf[vb] = __builtin_bit_cast(bf16x8, w); }
#pragma unroll
                for (int tb = 0; tb < 4; ++tb) { const LAS short* qp = Qs + (16 * tb + l15) * PQ + 32 * ks + 4 * g4; const u32x2 q0 = *(const LAS u32x2*)qp, q1 = *(const LAS u32x2*)(qp + 16);
                    u32x4 qw; qw.x = q0.x; qw.y = q0.y; qw.z = q1.x; qw.w = q1.y; const bf16x8 Qf = __builtin_bit_cast(bf16x8, qw);
#pragma unroll
                    for (int vb = 0; vb < 2; ++vb) acc[vb][tb] = __builtin_amdgcn_mfma_f32_16x16x32_bf16(Cf[vb], Qf, acc[vb][tb], 0, 0, 0); } }
#pragma unroll
            for (int tb = 0; tb < 4; ++tb) { const float si_t = shi(si, 16 * tb + l15); acc[0][tb] = acc[0][tb] * si_t; acc[1][tb] = acc[1][tb] * si_t; }
            bf16x8 Vf[2][2];
#pragma unroll
            for (int vb = 0; vb < 2; ++vb)
#pragma unroll
                for (int ks = 0; ks < 2; ++ks) Vf[vb][ks] = tr_frag(Vs, PV, 32 * ks, 32 * wave + 16 * vb, lane);
#pragma unroll
            for (int ks = 0; ks < 2; ++ks)
#pragma unroll
                for (int tb = 0; tb < 4; ++tb) { const bf16x8 Pf = *(const LAS bf16x8*)(Ps + (16 * tb + l15) * PP + 32 * ks + 8 * g4);
#pragma unroll
                    for (int vb = 0; vb < 2; ++vb) acc[vb][tb] = __builtin_amdgcn_mfma_f32_16x16x32_bf16(Vf[vb][ks], Pf, acc[vb][tb], 0, 0, 0); }
            { const int t = tid >> 3, part = tid & 7; const u32x4 pw = *(const LAS u32x4*)(Ps + t * PP + 8 * part);
              const float psum = (bf_lo(pw.x) + bf_hi(pw.x)) + (bf_lo(pw.y) + bf_hi(pw.y)) + (bf_lo(pw.z) + bf_hi(pw.z)) + (bf_lo(pw.w) + bf_hi(pw.w));
              const u32x4 qa = *(const LAS u32x4*)(Qs + t * PQ + 16 * part), qb = *(const LAS u32x4*)(Qs + t * PQ + 16 * part + 8); const LAS float* nv = fv + F_N + 16 * part;
              float qn = bf_lo(qa.x) * nv[0] + bf_hi(qa.x) * nv[1] + bf_lo(qa.y) * nv[2] + bf_hi(qa.y) * nv[3] + bf_lo(qa.z) * nv[4] + bf_hi(qa.z) * nv[5] + bf_lo(qa.w) * nv[6] + bf_hi(qa.w) * nv[7]
                       + bf_lo(qb.x) * nv[8] + bf_hi(qb.x) * nv[9] + bf_lo(qb.y) * nv[10] + bf_hi(qb.y) * nv[11] + bf_lo(qb.z) * nv[12] + bf_hi(qb.z) * nv[13] + bf_lo(qb.w) * nv[14] + bf_hi(qb.w) * nv[15];
              float den = psum + fv[F_SI + t] * qn; den += shx(den, 1, lane); den += shx(den, 2, lane); den += shx(den, 4, lane);
              if (part == 0) fv[F_HD + t] = __builtin_amdgcn_rcpf(fmaxf(fabsf(den), __expf(-(fv[F_B + t] + fv[F_PM + t])))); }
            __syncthreads();
#pragma unroll
            for (int tb = 0; tb < 4; ++tb) { const float hd = fv[F_HD + 16 * tb + l15]; float ss = 0.f;
#pragma unroll
                for (int vb = 0; vb < 2; ++vb) { acc[vb][tb] = acc[vb][tb] * hd; const f32x4 v = acc[vb][tb]; ss += (v[0] * v[0] + v[1] * v[1]) + (v[2] * v[2] + v[3] * v[3]); }
                ss += shx(ss, 16, lane); ss += shx(ss, 32, lane);
                if (lane < 16) fv[F_SSQ + wave * 64 + 16 * tb + lane] = ss; }
            if (tid < 128) { float s = 0.f;
#pragma unroll 8
                for (int s_ = 0; s_ < 64; ++s_) s += bf2f((unsigned short)KWs[s_ * PQ + tid]);
                fv[F_N + tid] = g.decay * fv[F_N + tid] + s; }
            u32x2 owr[2][4];
#pragma unroll
            for (int tb = 0; tb < 4; ++tb)
#pragma unroll
                for (int vb = 0; vb < 2; ++vb) owr[vb][tb] = *(const u32x2*)(Og + (row0 + 16 * tb + l15) * 2048 + h * 256 + 32 * wave + 16 * vb + 4 * g4);
            state_update(C, Vf, KWs, g.decay, lane);
            __syncthreads();
#pragma unroll
            for (int tb = 0; tb < 4; ++tb) { const int t = 16 * tb + l15; float tot = 0.f;
#pragma unroll
                for (int w = 0; w < 8; ++w) tot += fv[F_SSQ + w * 64 + t];
                const float rs = rsqrtf(tot * (1.0f / 256.0f) + RMS_EPS);
#pragma unroll
                for (int vb = 0; vb < 2; ++vb) { const int col = h * 256 + 32 * wave + 16 * vb + 4 * g4; const f32x4 hn = hnr[vb];
                    const u32x2 ow = owr[vb][tb]; const f32x4 v = acc[vb][tb];
                    u32x2 w; w.x = cvt_pk_bf16(v[0] * rs * hn[0] * bf_lo(ow.x), v[1] * rs * hn[1] * bf_hi(ow.x)); w.y = cvt_pk_bf16(v[2] * rs * hn[2] * bf_lo(ow.y), v[3] * rs * hn[3] * bf_hi(ow.y));
                    *(u32x2*)(HG + (row0 + t) * 2048 + col) = w; } }
            m = g.m_new;
            if (ch < 7) gs = gate_scan(igr, lfr, lane);
        }
    }
}

__device__ __forceinline__ void rg_conv(KA a, int gtid, int nthr) {
    const bf16_t* REC = (const bf16_t*)(a.ws + WS_R1); bf16_t* XC = (bf16_t*)(a.ws + WS_R2); const float* cw = a.in[I_RCW]; const float* cb = a.in[I_RCB];
    for (int e = gtid; e < (M_ / 16) * 256; e += nthr) { const int rg = e >> 8, c0 = (e & 255) * 8, row0 = rg * 16, t0 = row0 & (S_ - 1);
        u32x4 v[19];
#pragma unroll
        for (int i = 0; i < 19; ++i) { if (t0 + i - 3 >= 0) v[i] = *(const u32x4*)(REC + (size_t)(row0 + i - 3) * 2048 + c0); else v[i] = (u32x4){0u, 0u, 0u, 0u}; }
        f32x4 w0[4], w1[4];
#pragma unroll
        for (int j = 0; j < 4; ++j) { w0[j] = *(const f32x4*)(cw + j * 2048 + c0); w1[j] = *(const f32x4*)(cw + j * 2048 + c0 + 4); }
        const f32x4 b0 = *(const f32x4*)(cb + c0), b1 = *(const f32x4*)(cb + c0 + 4);
#pragma unroll
        for (int r = 0; r < 16; ++r) { f32x4 o0 = b0, o1 = b1;
#pragma unroll
            for (int j = 0; j < 4; ++j) { const u32x4 x = v[r + j];
                o0[0] += w0[j][0] * bf_lo(x.x); o0[1] += w0[j][1] * bf_hi(x.x); o0[2] += w0[j][2] * bf_lo(x.y); o0[3] += w0[j][3] * bf_hi(x.y);
                o1[0] += w1[j][0] * bf_lo(x.z); o1[1] += w1[j][1] * bf_hi(x.z); o1[2] += w1[j][2] * bf_lo(x.w); o1[3] += w1[j][3] * bf_hi(x.w); }
            u32x4 w; w.x = cvt_pk_bf16(o0[0], o0[1]); w.y = cvt_pk_bf16(o0[2], o0[3]); w.z = cvt_pk_bf16(o1[0], o1[1]); w.w = cvt_pk_bf16(o1[2], o1[3]);
            *(u32x4*)(XC + (size_t)(row0 + r) * 2048 + c0) = w; } }
}
__device__ __forceinline__ void rg_scan1(KA a, int gtid, int nthr) {
    const bf16_t* LA = (const bf16_t*)(a.ws + WS_R3); const bf16_t* U = (const bf16_t*)(a.ws + WS_R1); float* SP = (float*)(a.ws + WS_SP); float* SH = (float*)(a.ws + WS_SH);
    for (int it = gtid; it < 131072; it += nthr) { const int c = (it & 1023) * 2, j = (it >> 10) & 63, b = it >> 16; const size_t base = ((size_t)b * S_ + j * 128) * 2048 + c;
        float h0 = 0.f, h1 = 0.f, s0 = 0.f, s1 = 0.f; unsigned la[2][16], uu[2][16];
#pragma unroll
        for (int t = 0; t < 16; ++t) { la[0][t] = *(const unsigned*)(LA + base + (size_t)t * 2048); uu[0][t] = *(const unsigned*)(U + base + (size_t)t * 2048); }
#pragma unroll
        for (int bt = 0; bt < 8; ++bt) { const int cur = bt & 1, nxt = cur ^ 1;
            if (bt < 7) {
#pragma unroll
                for (int t = 0; t < 16; ++t) { const size_t off = base + (size_t)((bt + 1) * 16 + t) * 2048; la[nxt][t] = *(const unsigned*)(LA + off); uu[nxt][t] = *(const unsigned*)(U + off); } }
#pragma unroll
            for (int t = 0; t < 16; ++t) { const float l0 = bf_lo(la[cur][t]), l1 = bf_hi(la[cur][t]); s0 += l0; s1 += l1; h0 = __expf(l0) * h0 + bf_lo(uu[cur][t]); h1 = __expf(l1) * h1 + bf_hi(uu[cur][t]); } }
        const size_t o = ((size_t)b * 64 + j) * 2048 + c; SP[o] = s0; SP[o + 1] = s1; SH[o] = h0; SH[o + 1] = h1; }
}
__device__ __forceinline__ void rg_scan2(KA a, int gtid, int nthr) {
    const bf16_t* LA = (const bf16_t*)(a.ws + WS_R3); const bf16_t* U = (const bf16_t*)(a.ws + WS_R1); const bf16_t* GG = (const bf16_t*)(a.ws + WS_R0); bf16_t* YB = (bf16_t*)(a.ws + WS_R2);
    const float* SP = (const float*)(a.ws + WS_SP); const float* SH = (const float*)(a.ws + WS_SH);
    for (int it = gtid; it < 131072; it += nthr) { const int c = (it & 1023) * 2, j = (it >> 10) & 63, b = it >> 16; const size_t base = ((size_t)b * S_ + j * 128) * 2048 + c;
        unsigned la[2][16], uu[2][16], gg[2][16];
#pragma unroll
        for (int t = 0; t < 16; ++t) { const size_t off = base + (size_t)t * 2048; la[0][t] = *(const unsigned*)(LA + off); uu[0][t] = *(const unsigned*)(U + off); gg[0][t] = *(const unsigned*)(GG + off); }
        float h0 = 0.f, h1 = 0.f;
        for (int j0 = 0; j0 < j; j0 += 8) { f32x2_ sp[8], sh[8];
#pragma unroll
            for (int q = 0; q < 8; ++q) { const size_t o = ((size_t)b * 64 + (j0 + q < j ? j0 + q : 0)) * 2048 + c; sp[q] = *(const f32x2_*)(SP + o); sh[q] = *(const f32x2_*)(SH + o); }
#pragma unroll
            for (int q = 0; q < 8; ++q) if (j0 + q < j) { h0 = __expf(sp[q].x) * h0 + sh[q].x; h1 = __expf(sp[q].y) * h1 + sh[q].y; } }
#pragma unroll
        for (int bt = 0; bt < 8; ++bt) { const int cur = bt & 1, nxt = cur ^ 1;
            if (bt < 7) {
#pragma unroll
                for (int t = 0; t < 16; ++t) { const size_t off = base + (size_t)((bt + 1) * 16 + t) * 2048; la[nxt][t] = *(const unsigned*)(LA + off); uu[nxt][t] = *(const unsigned*)(U + off); gg[nxt][t] = *(const unsigned*)(GG + off); } }
#pragma unroll
            for (int t = 0; t < 16; ++t) { const size_t off = base + (size_t)(bt * 16 + t) * 2048;
                h0 = __expf(bf_lo(la[cur][t])) * h0 + bf_lo(uu[cur][t]); h1 = __expf(bf_hi(la[cur][t])) * h1 + bf_hi(uu[cur][t]);
                *(unsigned*)(YB + off) = cvt_pk_bf16(bf_lo(gg[cur][t]) * h0, bf_hi(gg[cur][t]) * h1); } }
    }
}
__device__ __forceinline__ void final_norm(KA a, int gw, int NGW, int lane) {
    const float* ssqp = (const float*)(a.ws + WS_SSQ) + 4 * SSQ_STAGE; const float* gf = a.in[I_NFIN]; const bf16_t* HBp = (const bf16_t*)(a.ws + WS_HB);
    f32x4 g[8];
#pragma unroll
    for (int i = 0; i < 4; ++i) { g[2 * i] = *(const f32x4*)(gf + i * 512 + lane * 8); g[2 * i + 1] = *(const f32x4*)(gf + i * 512 + lane * 8 + 4); }
    for (int row = gw; row < M_; row += NGW) {
        float t = ssqp[(size_t)row * 32 + (lane & 31)];
        u32x4 v[4];
#pragma unroll
        for (int i = 0; i < 4; ++i) v[i] = *(const u32x4*)(HBp + (size_t)row * 2048 + i * 512 + lane * 8);
#pragma unroll
        for (int o = 1; o < 32; o <<= 1) t += shx(t, o, lane);
        const float r = rsqrtf(t * (1.0f / 2048.0f) + RMS_EPS);
#pragma unroll
        for (int i = 0; i < 4; ++i) { float* o = a.out + (size_t)row * 2048 + i * 512 + lane * 8; const f32x4 g0 = g[2 * i], g1 = g[2 * i + 1];
            *(f32x4*)o = (f32x4){bf_lo(v[i].x) * r * g0[0], bf_hi(v[i].x) * r * g0[1], bf_lo(v[i].y) * r * g0[2], bf_hi(v[i].y) * r * g0[3]};
            *(f32x4*)(o + 4) = (f32x4){bf_lo(v[i].z) * r * g1[0], bf_hi(v[i].z) * r * g1[1], bf_lo(v[i].w) * r * g1[2], bf_hi(v[i].w) * r * g1[3]}; }
    }
}

#define GRID_BAR() do { XcdBarrier xb_ = xbar; asm volatile("" : "+s"(xb_.bar), "+s"(xb_.x)); xcd_barrier(xb_); } while (0)
#ifndef REP_NULL
#define REP_NULL 0
#endif
#ifndef REP_SCAN
#define REP_SCAN 1
#endif
#ifndef REP_GATES
#define REP_GATES 1
#endif
#ifndef REP_CONV
#define REP_CONV 1
#endif
#ifndef REP_MLL
#define REP_MLL 1
#endif
#ifndef REP_MLO
#define REP_MLO 1
#endif
#ifndef REP_PRO
#define REP_PRO 1
#endif
#ifndef REP_G1
#define REP_G1 1
#endif
#ifndef REP_ML
#define REP_ML 1
#endif
#ifndef REP_FFN
#define REP_FFN 1
#endif
#ifndef REP_RG
#define REP_RG 1
#endif
#ifndef REP_G5
#define REP_G5 1
#endif
#ifndef EXTRA_SYNC
#define EXTRA_SYNC 0
#endif
__global__ void __launch_bounds__(NTHR, 2) fwd_megakernel(Args a_by_value) {
    extern __shared__ __attribute__((aligned(16))) unsigned char lds_raw[];
    LAS unsigned char* lds = (LAS unsigned char*)lds_raw;
    cg::grid_group grid = cg::this_grid();
    if (threadIdx.x == 0) { ((volatile LAS unsigned*)(lds + LDS_MISC))[0] = 0u; ((volatile LAS unsigned*)(lds + LDS_MISC))[1] = 0u; }
    __syncthreads();
    const XcdBarrier xbar = xcd_barrier_post((unsigned*)(a_by_value.ws + WS_BAR), (volatile LAS unsigned*)(lds + LDS_MISC));
    const int wave0 = __builtin_amdgcn_readfirstlane(threadIdx.x >> 6);
#define KARGS() const __attribute__((address_space(4))) Args* kap_ = (const __attribute__((address_space(4))) Args*)__builtin_amdgcn_kernarg_segment_ptr(); asm volatile("" : "+s"(kap_)); KA a = *kap_
#define IDS() KARGS(); const int lane = launder_v(__builtin_amdgcn_mbcnt_hi(~0u, __builtin_amdgcn_mbcnt_lo(~0u, 0u))), wave = launder_s(wave0), tid = wave * 64 + lane, bid = launder_s(blockIdx.x), gtid = bid * NTHR + tid; (void)lane; (void)wave; (void)gtid
    const int G = gridDim.x, nthr = G * NTHR;
#define ssq ((float*)(a.ws + WS_SSQ))
#define HB ((bf16_t*)(a.ws + WS_HB))

    for (int rep = 0; rep < REP_PRO; ++rep) { { IDS(); prologue(a, lds, bid, G, lane, wave); }
    GRID_BAR(); }
    if (gridDim.x > 65536u) grid.sync();
    for (int rep = 0; rep < EXTRA_SYNC; ++rep) GRID_BAR();
#define GEMM_RES(AOFF, WOFF, KK, SSQI) { KARGS(); pg8::Gemm g{(const bf16_t*)(a.ws + (AOFF)), (const bf16_t*)(a.ws + (WOFF)), M_, 2048, (KK), (KK), (KK), wave0}; pg8::StaticOrder S; S.init(M_, 2048, G, (int)blockIdx.x); \
        pg8::EpiResidual E{HB, ssq + (size_t)(SSQI) * SSQ_STAGE}; pg8::gemm_phase<pg8::EpiResidual, pg8::StaticOrder, true, true>(lds, g, S, E); } GRID_BAR()
#define GEMM_FFN_IN(WOFF, SSQI) { KARGS(); pg8::Gemm g{HB, (const bf16_t*)(a.ws + (WOFF)), M_, 2 * DFF_, 2048, 2048, 2048, wave0}; pg8::StaticOrder S; S.init(M_, 2 * DFF_, G, (int)blockIdx.x); \
        pg8::EpiSwiglu E{(bf16_t*)(a.ws + WS_R0), ssq + (size_t)(SSQI) * SSQ_STAGE}; pg8::gemm_phase<pg8::EpiSwiglu, pg8::StaticOrder, true, true>(lds, g, S, E); } GRID_BAR()
    for (int rep = 0; rep < REP_G1; ++rep) { if (rep) GRID_BAR(); KARGS(); pg8::Gemm g{HB, (const bf16_t*)(a.ws + WS_WM_IN), M_, 6144, 2048, 2048, 2048, wave0}; pg8::StaticOrder S; S.init(M_, 6144, G, (int)blockIdx.x);
      pg8::EpiMlstmIn E{(bf16_t*)(a.ws + WS_R0), (bf16_t*)(a.ws + WS_R0 + 32 * MiB), (bf16_t*)(a.ws + WS_R1), (bf16_t*)(a.ws + WS_R2), ssq};
      pg8::gemm_phase<pg8::EpiMlstmIn, pg8::StaticOrder, true, true>(lds, g, S, E); }
    GRID_BAR();
    for (int rep = 0; rep < REP_ML * REP_MLL; ++rep) { { IDS(); mlstm_local(a, lds, tid, lane, wave); }
    GRID_BAR(); }
    { IDS(); mlstm_scan(a, lds, tid, gtid, nthr); }
    GRID_BAR();
    for (int rep = 0; rep < REP_ML * REP_MLO; ++rep) { { IDS(); mlstm_out(a, lds, tid, lane, wave); }
    GRID_BAR(); }
    GEMM_RES(WS_R3, WS_WM_OUT, 2048, 1);
    for (int rep = 0; rep < REP_FFN; ++rep) { GEMM_FFN_IN(WS_WF_IN0, 1); }
    for (int rep = 0; rep < REP_NULL; ++rep) { { KARGS(); pg8::Gemm g{HB, (const bf16_t*)(a.ws + WS_WF_IN0), M_, 2 * DFF_, 2048, 2048, 2048, wave0}; pg8::StaticOrder S; S.init(M_, 2 * DFF_, G, (int)blockIdx.x);
        pg8::EpiNull E{(float*)(a.ws + WS_SP)}; pg8::gemm_phase<pg8::EpiNull, pg8::StaticOrder, true, true>(lds, g, S, E); } GRID_BAR(); }
    GEMM_RES(WS_R0, WS_WF_OUT0, DFF_, 2);
    for (int rep = 0; rep < REP_G5; ++rep) { if (rep) GRID_BAR(); KARGS(); pg8::Gemm g{HB, (const bf16_t*)(a.ws + WS_WR_IN), M_, 4096, 2048, 2048, 2048, wave0}; pg8::StaticOrder S; S.init(M_, 4096, G, (int)blockIdx.x);
      pg8::EpiRgIn E{(bf16_t*)(a.ws + WS_R0), (bf16_t*)(a.ws + WS_R1), ssq + 2 * SSQ_STAGE};
      pg8::gemm_phase<pg8::EpiRgIn, pg8::StaticOrder, true, true>(lds, g, S, E); }
    GRID_BAR();
    for (int rep = 0; rep < REP_RG * REP_CONV; ++rep) { { IDS(); rg_conv(a, gtid, nthr); }
    GRID_BAR(); }
    for (int rep = 0; rep < REP_RG * REP_GATES; ++rep) { if (rep) GRID_BAR(); KARGS(); pg8::Gemm g{(const bf16_t*)(a.ws + WS_R2), (const bf16_t*)(a.ws + WS_WG), M_, 4096, 256, 2048, 256, wave0}; pg8::GateOrder S; S.init(M_, 4096, G, (int)blockIdx.x);
      pg8::EpiRgGates E{(const bf16_t*)(a.ws + WS_R2), (bf16_t*)(a.ws + WS_R3), (bf16_t*)(a.ws + WS_R1), a.in[I_RGB], a.in[I_RAP]};
      pg8::gemm_phase<pg8::EpiRgGates, pg8::GateOrder, true, true>(lds, g, S, E); }
    GRID_BAR();
    for (int rep = 0; rep < REP_RG * REP_SCAN; ++rep) { { IDS(); rg_scan1(a, gtid, nthr); }
    GRID_BAR(); }
    for (int rep = 0; rep < REP_RG * REP_SCAN; ++rep) { { IDS(); rg_scan2(a, gtid, nthr); }
    GRID_BAR(); }
    GEMM_RES(WS_R2, WS_WR_OUT, 2048, 3);
    for (int rep = 0; rep < REP_FFN; ++rep) { GEMM_FFN_IN(WS_WF_IN1, 3); }
    GEMM_RES(WS_R0, WS_WF_OUT1, DFF_, 4);
    { IDS(); final_norm(a, bid * 8 + wave, G * 8, lane); }
}

extern "C" void kernel_launch(void* const* d_in, const int* in_sizes, int n_in, void* d_out, int out_size, void* d_ws, size_t ws_size, hipStream_t stream) {
    static int grid = 0;
    if (grid == 0) {
        if (n_in != 17 || out_size != M_ * D_ || ws_size < WS_END) { fprintf(stderr, "kernel_launch: unexpected problem (n_in %d, out %d, ws %zu)\n", n_in, out_size, ws_size); grid = -1; return; }
        int dev = 0, cus = 0, per_cu = 0;
        hipGetDevice(&dev); hipDeviceGetAttribute(&cus, hipDeviceAttributeMultiprocessorCount, dev);
        hipFuncSetAttribute((const void*)fwd_megakernel, hipFuncAttributeMaxDynamicSharedMemorySize, LDS_BYTES);
        hipOccupancyMaxActiveBlocksPerMultiprocessor(&per_cu, (const void*)fwd_megakernel, NTHR, LDS_BYTES);
        if (per_cu < 1) { fprintf(stderr, "kernel_launch: occupancy query says %d blocks per CU\n", per_cu); per_cu = 1; }
        (void)hipGetLastError();
        grid = cus * 1;
    }
    if (grid < 0) return;
    Args a{};
    for (int i = 0; i < 17; ++i) a.in[i] = (const float*)d_in[i];
    a.out = (float*)d_out; a.ws = (unsigned char*)d_ws;
    (void)hipMemsetAsync((char*)d_ws + WS_BAR, 0, BAR_BYTES, stream);
    void* args[] = {&a};
    hipError_t e = hipLaunchCooperativeKernel((const void*)fwd_megakernel, dim3(grid), dim3(NTHR), args, LDS_BYTES, stream);
    if (e != hipSuccess) fprintf(stderr, "cooperative launch failed: %s (grid %d)\n", hipGetErrorString(e), grid);
}
```

```cpp
#include <hip/hip_runtime.h>
#include <hip/hip_cooperative_groups.h>
#include <cstdio>
namespace cg = cooperative_groups;

namespace pg8 {
#define PG8_LAS __attribute__((address_space(3)))
typedef unsigned short bf16_t;
typedef short bf16x8 __attribute__((ext_vector_type(8)));
typedef float f32x4 __attribute__((ext_vector_type(4)));
typedef unsigned u32x4 __attribute__((ext_vector_type(4)));
constexpr int BM = 256, BK = 64, HALF = 128, HTB = HALF * BK * 2  , STAGE_BYTES = 8 * HTB, NXCD = 8, WGM = 8;

__host__ __device__ __forceinline__ int lds_byte(int r, int c) { const int st = (r >> 4) * 2 + (c >> 5), rr = r & 15, cc = c & 31, ob = rr * 64 + cc * 2; return st * 1024 + (ob ^ (((ob >> 9) & 1) << 5)); }
__host__ __device__ __forceinline__ void stage_rc(int b, int& R, int& C) { const int st = b / 1024, sb = b % 1024, swz = sb ^ (((sb >> 9) & 1) << 5); R = (st >> 1) * 16 + swz / 64; C = (st & 1) * 32 + (swz % 64) / 2; }
__host__ __device__ __forceinline__ int perm32(int rho) { const int n = rho >> 4, i = rho & 15; return 8 * (i >> 2) + 4 * n + (i & 3); }
struct Unit { int pm, pn, aoff; };
struct Gemm { const bf16_t* A; const bf16_t* Bt; int M, N, K, lda, ldb, wave; };
struct StaticOrder {
    int nM, nN, nwg, G, c;
    __host__ __device__ void init(int M, int N, int G_, int c_) { nM = M / BM; nN = N / BM; nwg = nM * nN; G = G_; c = c_; }
    __host__ __device__ bool next(int i, Unit& u) const {
        const long L = (long)i * G + c; if (L >= nwg) return false;
        int wgid = (int)L; { const int q = nwg / NXCD, r = nwg % NXCD, xcd = wgid % NXCD, off = wgid / NXCD; wgid = (xcd < r ? xcd * (q + 1) : r * (q + 1) + (xcd - r) * q) + off; }
        const int nig = WGM * nN, gid = wgid / nig, fm = gid * WGM, gsz = (nM - fm) < WGM ? (nM - fm) : WGM;
        u.pm = fm + ((wgid % nig) % gsz); u.pn = (wgid % nig) / gsz; u.aoff = 0; return true;
    }
    __device__ __forceinline__ void a_ready(const Unit&) const {}
    __device__ __forceinline__ void done(const Unit&) const {}
};
__device__ __forceinline__ unsigned cvt_pk_bf16(float lo, float hi) { unsigned r; asm volatile("v_cvt_pk_bf16_f32 %0, %1, %2" : "=v"(r) : "v"(lo), "v"(hi)); return r; }
typedef float f32x2 __attribute__((ext_vector_type(2)));
template <class Epi, class Sched, bool ALIGN_EPI = false, bool SP2 = false>
__device__ __forceinline__ void gemm_phase(PG8_LAS unsigned char* lds, const Gemm g, const Sched& S, const Epi& E) {
    int lane_ = __builtin_amdgcn_mbcnt_hi(~0u, __builtin_amdgcn_mbcnt_lo(~0u, 0u)); asm volatile("" : "+v"(lane_));
    const int wid = g.wave, tid = wid * 64 + lane_, lane = tid & 63, wr = wid >> 2, wc = wid & 3, fr = lane & 15, fq = lane >> 4;
    const int K = g.K, nt = K / BK;
    unsigned voffA[2], voffB[2];
#pragma unroll
    for (int i = 0; i < 2; ++i) { int R, C; stage_rc(tid * 16 + i * 8192, R, C); const int Rb = Epi::PERM ? ((R & ~31) + perm32(R & 31)) : R;
        voffA[i] = (unsigned)(R * g.lda + C) * 2u; voffB[i] = (unsigned)(Rb * g.ldb + C) * 2u; }
    constexpr unsigned kstep = (unsigned)(BK * 2);
    const unsigned hstepA = (unsigned)HALF * g.lda * 2u, hstepB = (unsigned)HALF * g.ldb * 2u;
    const unsigned tstepA = 2u * hstepA, tstepB = 2u * hstepB;
    const unsigned ldsw = (unsigned)wid * 1024u;
    const int aoff = lds_byte(wr * 64 + fr, fq * 8), boff = lds_byte(wc * 32 + fr, fq * 8);
#define PG8_SA(b, h) (((b) * 2 + (h)) * HTB)
#define PG8_SB(b, h) ((4 + (b) * 2 + (h)) * HTB)
#define PG8_STAGE(bufoff, gbase, voff) do { _Pragma("unroll") for (int _i = 0; _i < 2; ++_i) \
        __builtin_amdgcn_global_load_lds((const unsigned*)((const char*)(gbase) + (voff)[_i]), (PG8_LAS unsigned*)(lds + (bufoff) + ldsw + _i * 8192), 16, 0, 0); } while (0)
#define PG8_LDA(dst, b, h) do { _Pragma("unroll") for (int m = 0; m < 4; ++m) _Pragma("unroll") for (int k = 0; k < 2; ++k) dst[m][k] = *(const PG8_LAS bf16x8*)(lds + PG8_SA(b, h) + aoff + m * 2048 + k * 1024); } while (0)
#define PG8_LDB(dst, b, h) do { _Pragma("unroll") for (int n = 0; n < 2; ++n) _Pragma("unroll") for (int k = 0; k < 2; ++k) dst[n][k] = *(const PG8_LAS bf16x8*)(lds + PG8_SB(b, h) + boff + n * 2048 + k * 1024); } while (0)
#define PG8_MMA(ai, bj, At, Bt) do { __builtin_amdgcn_s_setprio(1); _Pragma("unroll") for (int m = 0; m < 4; ++m) _Pragma("unroll") for (int n = 0; n < 2; ++n) _Pragma("unroll") for (int k = 0; k < 2; ++k) \
        acc[ai][bj][m][n] = __builtin_amdgcn_mfma_f32_16x16x32_bf16(Bt[n][k], At[m][k], acc[ai][bj][m][n], 0, 0, 0); __builtin_amdgcn_s_setprio(0); } while (0)
#define PG8_WAIT_V(n) asm volatile("s_waitcnt vmcnt(" #n ")" ::: "memory")
#define PG8_WAIT_L(n) asm volatile("s_waitcnt lgkmcnt(" #n ")" ::: "memory")
#define PG8_BAR __builtin_amdgcn_s_barrier()
#define PG8_SCHED __builtin_amdgcn_sched_barrier(0)
    Unit cur, nxt; int ui = 0;
    if (!S.next(0, cur)) return;
    f32x4 acc[2][2][4][2];
#pragma unroll
    for (int a = 0; a < 2; ++a)
#pragma unroll
        for (int b = 0; b < 2; ++b)
#pragma unroll
            for (int m = 0; m < 4; ++m)
#pragma unroll
                for (int n = 0; n < 2; ++n) acc[a][b][m][n] = (f32x4){0.f, 0.f, 0.f, 0.f};
    bf16x8 At[4][2], B0[2][2], B1[2][2];
    const char* cA = (const char*)g.A + (size_t)cur.pm * tstepA + cur.aoff; const char* cB = (const char*)g.Bt + (size_t)cur.pn * tstepB;
    S.a_ready(cur);
    if constexpr (SP2) {
        PG8_STAGE(PG8_SB(0, 0), cB, voffB); PG8_STAGE(PG8_SB(0, 1), cB + hstepB, voffB); PG8_STAGE(PG8_SA(0, 0), cA, voffA); PG8_STAGE(PG8_SA(0, 1), cA + hstepA, voffA);
        if (wr == 1) PG8_BAR;
        PG8_WAIT_V(2); PG8_BAR;
        PG8_STAGE(PG8_SB(1, 0), cB + kstep, voffB); PG8_STAGE(PG8_SA(1, 0), cA + kstep, voffA); PG8_STAGE(PG8_SB(1, 1), cB + hstepB + kstep, voffB);
        PG8_WAIT_V(6); PG8_BAR;
    } else {
        PG8_STAGE(PG8_SB(0, 0), cB, voffB); PG8_STAGE(PG8_SA(0, 0), cA, voffA); PG8_STAGE(PG8_SB(0, 1), cB + hstepB, voffB); PG8_STAGE(PG8_SA(0, 1), cA + hstepA, voffA);
        if (wr == 1) PG8_BAR;
        PG8_WAIT_V(4); PG8_BAR;
        PG8_STAGE(PG8_SB(1, 0), cB + kstep, voffB); PG8_STAGE(PG8_SA(1, 0), cA + kstep, voffA); PG8_STAGE(PG8_SB(1, 1), cB + hstepB + kstep, voffB);
        PG8_WAIT_V(6); PG8_BAR;
    }
    for (;;) {
        const bool has_next = S.next(ui + 1, nxt);
        const char* nA = has_next ? (const char*)g.A + (size_t)nxt.pm * tstepA + nxt.aoff : cA; const char* nB = has_next ? (const char*)g.Bt + (size_t)nxt.pn * tstepB : cB;
        for (int t = 0; t < nt; t += 2) {
            const bool last = (t == nt - 2);
            const char* a1 = cA + (size_t)(t + 1) * kstep;
            const char* a2 = last ? nA : cA + (size_t)(t + 2) * kstep; const char* b2 = last ? nB : cB + (size_t)(t + 2) * kstep;
            const char* a3 = a2 + kstep; const char* b3 = b2 + kstep;
            if (last && has_next) S.a_ready(nxt);
            if constexpr (SP2) {
            PG8_LDB(B0, 0, 0); PG8_LDB(B1, 0, 1); PG8_SCHED; PG8_LDA(At, 0, 0); PG8_STAGE(PG8_SA(1, 1), a1 + hstepA, voffA);
            PG8_WAIT_V(8); PG8_WAIT_L(0); PG8_BAR; PG8_MMA(0, 0, At, B0); PG8_MMA(0, 1, At, B1); PG8_BAR; PG8_SCHED;
            PG8_LDA(At, 0, 1); PG8_STAGE(PG8_SB(0, 0), b2, voffB); PG8_STAGE(PG8_SB(0, 1), b2 + hstepB, voffB); PG8_STAGE(PG8_SA(0, 0), a2, voffA);
            PG8_WAIT_V(8); PG8_WAIT_L(0); PG8_BAR; PG8_MMA(1, 0, At, B0); PG8_MMA(1, 1, At, B1); PG8_BAR; PG8_SCHED;
            PG8_LDB(B0, 1, 0); PG8_LDB(B1, 1, 1); PG8_SCHED; PG8_LDA(At, 1, 0); PG8_STAGE(PG8_SA(0, 1), a2 + hstepA, voffA);
            PG8_WAIT_V(8); PG8_WAIT_L(0); PG8_BAR; PG8_MMA(0, 0, At, B0); PG8_MMA(0, 1, At, B1); PG8_BAR; PG8_SCHED;
            PG8_LDA(At, 1, 1); PG8_STAGE(PG8_SB(1, 0), b3, voffB); PG8_STAGE(PG8_SB(1, 1), b3 + hstepB, voffB); PG8_STAGE(PG8_SA(1, 0), a3, voffA);
            PG8_WAIT_V(8); PG8_WAIT_L(0); PG8_BAR; PG8_MMA(1, 0, At, B0); PG8_MMA(1, 1, At, B1); PG8_BAR; PG8_SCHED;
            } else {
            PG8_LDB(B0, 0, 0); PG8_SCHED; PG8_LDA(At, 0, 0); PG8_STAGE(PG8_SA(1, 1), a1 + hstepA, voffA);
            PG8_WAIT_L(8); PG8_BAR; PG8_WAIT_L(0); PG8_MMA(0, 0, At, B0); PG8_BAR; PG8_SCHED;
            PG8_LDB(B1, 0, 1); PG8_STAGE(PG8_SB(0, 0), b2, voffB);
            PG8_BAR; PG8_WAIT_L(0); PG8_MMA(0, 1, At, B1); PG8_BAR;
            PG8_LDA(At, 0, 1); PG8_STAGE(PG8_SA(0, 0), a2, voffA);
            PG8_BAR; PG8_WAIT_L(0); PG8_MMA(1, 0, At, B0); PG8_BAR; PG8_SCHED;
            PG8_STAGE(PG8_SB(0, 1), b2 + hstepB, voffB);
            PG8_WAIT_V(6); PG8_BAR; PG8_MMA(1, 1, At, B1); PG8_BAR;
            PG8_LDB(B0, 1, 0); PG8_SCHED; PG8_LDA(At, 1, 0); PG8_STAGE(PG8_SA(0, 1), a2 + hstepA, voffA);
            PG8_WAIT_L(8); PG8_BAR; PG8_WAIT_L(0); PG8_MMA(0, 0, At, B0); PG8_BAR; PG8_SCHED;
            PG8_LDB(B1, 1, 1); PG8_STAGE(PG8_SB(1, 0), b3, voffB);
            PG8_BAR; PG8_WAIT_L(0); PG8_MMA(0, 1, At, B1); PG8_BAR;
            PG8_LDA(At, 1, 1); PG8_STAGE(PG8_SA(1, 0), a3, voffA);
            PG8_BAR; PG8_WAIT_L(0); PG8_MMA(1, 0, At, B0); PG8_BAR; PG8_SCHED;
            PG8_STAGE(PG8_SB(1, 1), b3 + hstepB, voffB);
            PG8_WAIT_V(6); PG8_BAR; PG8_MMA(1, 1, At, B1); PG8_BAR;
            }
        }
        if constexpr (ALIGN_EPI) { if (wr == 0) PG8_BAR; }
        if constexpr (!Epi::AFTER_DRAIN) { int ln_ = __builtin_amdgcn_mbcnt_hi(~0u, __builtin_amdgcn_mbcnt_lo(~0u, 0u)); asm volatile("" : "+v"(ln_)); E(acc, cur, wr, wc, ln_ & 15, ln_ >> 4); S.done(cur); }
        if (!has_next) break;
#pragma unroll
        for (int a = 0; a < 2; ++a)
#pragma unroll
            for (int b = 0; b < 2; ++b)
#pragma unroll
                for (int m = 0; m < 4; ++m)
#pragma unroll
                    for (int n = 0; n < 2; ++n) acc[a][b][m][n] = (f32x4){0.f, 0.f, 0.f, 0.f};
        cur = nxt; cA = nA; cB = nB; ++ui;
        if constexpr (ALIGN_EPI) { if (wr == 1) PG8_BAR; }
    }
    PG8_WAIT_V(0);
    if constexpr (!ALIGN_EPI) { if (wr == 0) PG8_BAR; }
    PG8_BAR;
    if constexpr (Epi::AFTER_DRAIN) { E.fused(acc, cur, wr, wc, fr, fq, lds, wid, lane); S.done(cur); }
#undef PG8_SA
#undef PG8_SB
#undef PG8_STAGE
#undef PG8_LDA
#undef PG8_LDB
#undef PG8_MMA
#undef PG8_WAIT_V
#undef PG8_WAIT_L
#undef PG8_BAR
#undef PG8_SCHED
}

typedef unsigned u32x2 __attribute__((ext_vector_type(2)));
constexpr float RMS_EPS = 1e-6f;
__device__ __forceinline__ float shx(float v, int mask, int lane) { return __int_as_float(__builtin_amdgcn_ds_bpermute((lane ^ mask) << 2, __float_as_int(v))); }
__device__ __forceinline__ float shi(float v, int src) { return __int_as_float(__builtin_amdgcn_ds_bpermute(src << 2, __float_as_int(v))); }
__device__ __forceinline__ float sigmoidf_(float x) { return __builtin_amdgcn_rcpf(1.0f + __expf(-x)); }
__device__ __forceinline__ float logsigmoidf_(float x) { const float e = __expf(-fabsf(x)), u = 1.0f + e, d = u - 1.0f; const float l = (d == 0.f) ? e : __logf(u) * (e * __builtin_amdgcn_rcpf(d)); return fminf(x, 0.f) - l; }
__device__ __forceinline__ float one_minus_exp(float y) { const float a = 1.0f - __expf(y), b = -y * (1.0f + y * (0.5f + y * (1.0f / 6.0f))); return (y > -0.01f) ? b : a; }
__device__ __forceinline__ float gelu_tanh(float x) { const float p = __builtin_fmaf(x * x, -0.10294325f, -2.3022082f); return x * __builtin_amdgcn_rcpf(1.0f + __builtin_amdgcn_exp2f(x * p)); }
__device__ __forceinline__ float bf_lo(unsigned w) { return __uint_as_float(w << 16); }
__device__ __forceinline__ float bf_hi(unsigned w) { return __uint_as_float(w & 0xffff0000u); }

__device__ __forceinline__ float row_rstd(const float* ssqp, int row, int fr, int fq) {
    const f32x4 p0 = *(const f32x4*)(ssqp + (size_t)row * 32 + fq * 8), p1 = *(const f32x4*)(ssqp + (size_t)row * 32 + fq * 8 + 4);
    float t = ((p0[0] + p0[1]) + (p0[2] + p0[3])) + ((p1[0] + p1[1]) + (p1[2] + p1[3])); const int ln = fr + 16 * fq;
    t += shx(t, 16, ln); t += shx(t, 32, ln);
    return rsqrtf(t * (1.0f / 2048.0f) + RMS_EPS);
}
struct EpiMlstmIn {
    static constexpr bool PERM = true, AFTER_DRAIN = false;
    bf16_t *Q, *Kb, *V, *O; const float* ssq;
    __device__ __forceinline__ void operator()(const f32x4 (&acc)[2][2][4][2], const Unit& u, int wr, int wc, int fr, int fq) const {
        const int row0 = u.pm * BM + wr * 64 + fr; const int pn = u.pn;
        bf16_t* base; int ldc, colt; bool sig = false;
        if (pn < 4) { base = Q; ldc = 1024; colt = pn * BM; } else if (pn < 8) { base = Kb; ldc = 1024; colt = (pn - 4) * BM; }
        else if (pn < 16) { base = V; ldc = 2048; colt = (pn - 8) * BM; } else { base = O; ldc = 2048; colt = (pn - 16) * BM; sig = true; }
        const int col0 = colt + wc * 32 + 8 * fq;
#pragma unroll
        for (int ai = 0; ai < 2; ++ai)
#pragma unroll
            for (int m = 0; m < 4; ++m) { const int row = row0 + ai * HALF + m * 16; const float rs = row_rstd(ssq, row, fr, fq);
                bf16_t* rowp = base + (size_t)row * ldc + col0;
#pragma unroll
                for (int bj = 0; bj < 2; ++bj) { f32x4 v0, v1;
                    if (sig) { const float nr = -1.4426950408889634f * rs;
#pragma unroll
                        for (int j = 0; j < 4; ++j) { v0[j] = __builtin_amdgcn_rcpf(1.0f + __builtin_amdgcn_exp2f(acc[ai][bj][m][0][j] * nr)); v1[j] = __builtin_amdgcn_rcpf(1.0f + __builtin_amdgcn_exp2f(acc[ai][bj][m][1][j] * nr)); } }
                    else { v0 = acc[ai][bj][m][0] * rs; v1 = acc[ai][bj][m][1] * rs; }
                    u32x4 w; w.x = cvt_pk_bf16(v0[0], v0[1]); w.y = cvt_pk_bf16(v0[2], v0[3]); w.z = cvt_pk_bf16(v1[0], v1[1]); w.w = cvt_pk_bf16(v1[2], v1[3]);
                    *(u32x4*)(rowp + bj * HALF) = w; }
                asm volatile("" ::: "memory"); }
    }
};
struct EpiResidual {
    static constexpr bool PERM = true, AFTER_DRAIN = false;
    bf16_t* HB; float* ssq_out;
    __device__ __forceinline__ void operator()(const f32x4 (&acc)[2][2][4][2], const Unit& u, int wr, int wc, int fr, int fq) const {
        const int row0 = u.pm * BM + wr * 64 + fr, col0 = u.pn * BM + wc * 32 + 8 * fq;
#pragma unroll
        for (int ai = 0; ai < 2; ++ai)
#pragma unroll
            for (int m = 0; m < 4; ++m) { const int row = row0 + ai * HALF + m * 16; bf16_t* bp = HB + (size_t)row * 2048 + col0; float s = 0.f;
                u32x4 hv[2];
#pragma unroll
                for (int bj = 0; bj < 2; ++bj) hv[bj] = *(const u32x4*)(bp + bj * HALF);
#pragma unroll
                for (int bj = 0; bj < 2; ++bj) { const f32x4 a0 = acc[ai][bj][m][0], a1 = acc[ai][bj][m][1]; const u32x4 x = hv[bj];
                    const float h0 = bf_lo(x.x) + a0[0], h1 = bf_hi(x.x) + a0[1], h2 = bf_lo(x.y) + a0[2], h3 = bf_hi(x.y) + a0[3], h4 = bf_lo(x.z) + a1[0], h5 = bf_hi(x.z) + a1[1], h6 = bf_lo(x.w) + a1[2], h7 = bf_hi(x.w) + a1[3];
                    s += (h0 * h0 + h1 * h1) + (h2 * h2 + h3 * h3) + (h4 * h4 + h5 * h5) + (h6 * h6 + h7 * h7);
                    u32x4 w; w.x = cvt_pk_bf16(h0, h1); w.y = cvt_pk_bf16(h2, h3); w.z = cvt_pk_bf16(h4, h5); w.w = cvt_pk_bf16(h6, h7); *(u32x4*)(bp + bj * HALF) = w; }
                { const int ln = fr + 16 * fq; s += shx(s, 16, ln); s += shx(s, 32, ln); }
                if (fq == 0) ssq_out[(size_t)row * 32 + u.pn * 4 + wc] = s;
                asm volatile("" ::: "memory"); }
    }
};
struct EpiSwiglu {
    static constexpr bool PERM = true, AFTER_DRAIN = false;
    bf16_t* ACT; const float* ssq;
    __device__ __forceinline__ void operator()(const f32x4 (&acc)[2][2][4][2], const Unit& u, int wr, int wc, int fr, int fq) const {
        const int row0 = u.pm * BM + wr * 64 + fr, ch0 = u.pn * 128 + wc * 32 + 8 * fq;
#pragma unroll
        for (int ai = 0; ai < 2; ++ai)
#pragma unroll
            for (int m = 0; m < 4; ++m) { const int row = row0 + ai * HALF + m * 16; const float rs = row_rstd(ssq, row, fr, fq), rs2 = rs * rs, nrl = -1.4426950408889634f * rs;
                float o[8];
#pragma unroll
                for (int n = 0; n < 2; ++n) { const f32x4 g = acc[ai][0][m][n], gu = g * acc[ai][1][m][n] * rs2;
#pragma unroll
                    for (int j = 0; j < 4; ++j) o[4 * n + j] = gu[j] * __builtin_amdgcn_rcpf(1.0f + __builtin_amdgcn_exp2f(g[j] * nrl)); }
                u32x4 w; w.x = cvt_pk_bf16(o[0], o[1]); w.y = cvt_pk_bf16(o[2], o[3]); w.z = cvt_pk_bf16(o[4], o[5]); w.w = cvt_pk_bf16(o[6], o[7]);
                *(u32x4*)(ACT + (size_t)row * 5632 + ch0) = w;
                asm volatile("" ::: "memory"); }
    }
};
struct EpiRgIn {
    static constexpr bool PERM = true, AFTER_DRAIN = false;
    bf16_t *GG, *REC; const float* ssq;
    __device__ __forceinline__ void operator()(const f32x4 (&acc)[2][2][4][2], const Unit& u, int wr, int wc, int fr, int fq) const {
        const int row0 = u.pm * BM + wr * 64 + fr; const bool gate = u.pn < 8;
        bf16_t* base = gate ? GG : REC; const int col0 = (gate ? u.pn : u.pn - 8) * BM + wc * 32 + 8 * fq;
#pragma unroll
        for (int ai = 0; ai < 2; ++ai)
#pragma unroll
            for (int m = 0; m < 4; ++m) { const int row = row0 + ai * HALF + m * 16; const float rs = row_rstd(ssq, row, fr, fq);
                bf16_t* rowp = base + (size_t)row * 2048 + col0;
#pragma unroll
                for (int bj = 0; bj < 2; ++bj) { f32x4 v0 = acc[ai][bj][m][0] * rs, v1 = acc[ai][bj][m][1] * rs;
                    if (gate) {
#pragma unroll
                        for (int j = 0; j < 4; ++j) { v0[j] = gelu_tanh(v0[j]); v1[j] = gelu_tanh(v1[j]); } }
                    u32x4 w; w.x = cvt_pk_bf16(v0[0], v0[1]); w.y = cvt_pk_bf16(v0[2], v0[3]); w.z = cvt_pk_bf16(v1[0], v1[1]); w.w = cvt_pk_bf16(v1[2], v1[3]);
                    *(u32x4*)(rowp + bj * HALF) = w; }
                asm volatile("" ::: "memory"); }
    }
};
struct EpiRgGates {
    static constexpr bool PERM = true, AFTER_DRAIN = false;
    const bf16_t* XC; bf16_t *LA, *U; const float *gate_b, *a_param;
    __device__ __forceinline__ void operator()(const f32x4 (&acc)[2][2][4][2], const Unit& u, int wr, int wc, int fr, int fq) const {
        const int row0 = u.pm * BM + wr * 64 + fr, blk = u.pn >> 1, lh = u.pn & 1;
        const int chb = 128 * lh + 32 * wc + 8 * fq, chg = blk * 256 + chb;
        f32x4 br[2], bi[2], ls[2];
        constexpr float NL2E = -1.4426950408889634f;
#pragma unroll
        for (int n = 0; n < 2; ++n) { br[n] = *(const f32x4*)(gate_b + blk * 512 + chb + 4 * n) * NL2E; bi[n] = *(const f32x4*)(gate_b + blk * 512 + 256 + chb + 4 * n) * NL2E;
            const f32x4 ap = *(const f32x4*)(a_param + chg + 4 * n);
#pragma unroll
            for (int j = 0; j < 4; ++j) ls[n][j] = 8.0f * logsigmoidf_(ap[j]); }
#pragma unroll
        for (int ai = 0; ai < 2; ++ai)
#pragma unroll
            for (int m = 0; m < 4; ++m) { const size_t rowoff = (size_t)(row0 + ai * HALF + m * 16) * 2048 + chg;
                const u32x4 xw = *(const u32x4*)(XC + rowoff);
                const float xc[8] = {bf_lo(xw.x), bf_hi(xw.x), bf_lo(xw.y), bf_hi(xw.y), bf_lo(xw.z), bf_hi(xw.z), bf_lo(xw.w), bf_hi(xw.w)}; float la[8], uu[8];
#pragma unroll
                for (int n = 0; n < 2; ++n)
#pragma unroll
                    for (int j = 0; j < 4; ++j) { const float r = __builtin_amdgcn_rcpf(1.0f + __builtin_amdgcn_exp2f(__builtin_fmaf(acc[ai][0][m][n][j], NL2E, br[n][j])));
                        const float ig = __builtin_amdgcn_rcpf(1.0f + __builtin_amdgcn_exp2f(__builtin_fmaf(acc[ai][1][m][n][j], NL2E, bi[n][j])));
                        const float l = r * ls[n][j]; la[4 * n + j] = l;
                        uu[4 * n + j] = __builtin_amdgcn_sqrtf(1.0f - __builtin_amdgcn_exp2f(l * 2.8853900817779268f)) * ig * xc[4 * n + j]; }
                u32x4 w; w.x = cvt_pk_bf16(la[0], la[1]); w.y = cvt_pk_bf16(la[2], la[3]); w.z = cvt_pk_bf16(la[4], la[5]); w.w = cvt_pk_bf16(la[6], la[7]); *(u32x4*)(LA + rowoff) = w;
                w.x = cvt_pk_bf16(uu[0], uu[1]); w.y = cvt_pk_bf16(uu[2], uu[3]); w.z = cvt_pk_bf16(uu[4], uu[5]); w.w = cvt_pk_bf16(uu[6], uu[7]); *(u32x4*)(U + rowoff) = w;
                asm volatile("" ::: "memory"); }
    }
};
struct EpiNull { static constexpr bool PERM = true, AFTER_DRAIN = false; float* sink;
    __device__ __forceinline__ void operator()(const f32x4 (&acc)[2][2][4][2], const Unit& u, int wr, int wc, int fr, int fq) const {
        float s = 0.f;
#pragma unroll
        for (int ai = 0; ai < 2; ++ai)
#pragma unroll
            for (int bj = 0; bj < 2; ++bj)
#pragma unroll
                for (int m = 0; m < 4; ++m)
#pragma unroll
                    for (int n = 0; n < 2; ++n) s += acc[ai][bj][m][n][0] + acc[ai][bj][m][n][1] + acc[ai][bj][m][n][2] + acc[ai][bj][m][n][3];
        if (s == 1.2345e-30f) sink[0] = s; } };
struct GateOrder : StaticOrder {
    __device__ bool next(int i, Unit& u) const { if (!StaticOrder::next(i, u)) return false; u.aoff = (u.pn >> 1) * 512; return true; }
};
}

#define LAS __attribute__((address_space(3)))
using pg8::bf16_t; using pg8::bf16x8; using pg8::f32x4; using pg8::u32x4; using pg8::u32x2; using pg8::cvt_pk_bf16; using pg8::bf_lo; using pg8::bf_hi; using pg8::RMS_EPS; using pg8::shx; using pg8::shi; using pg8::logsigmoidf_;
typedef short s16x4 __attribute__((ext_vector_type(4)));
typedef float f32x2_ __attribute__((ext_vector_type(2)));
constexpr int M_ = 16384, D_ = 2048, S_ = 8192, DFF_ = 5632, NTHR = 512;
constexpr size_t MiB = 1u << 20;
constexpr size_t WS_SSQ = 552 * MiB, SSQ_STAGE = (size_t)16384 * 32;
constexpr size_t WS_IG = 1 * MiB, WS_LF = 1 * MiB + 512 * 1024;
constexpr size_t WS_NL = 2 * MiB;
constexpr size_t WS_ML = 2 * MiB + 256 * 1024, WS_BT = WS_ML + 4096, WS_MS = WS_BT + 4096;
constexpr size_t WS_SP = 3 * MiB, WS_SH = 4 * MiB; constexpr size_t WS_BAR = 5 * MiB, BAR_BYTES = 16384;
constexpr int LDS_MISC = 131072;
constexpr size_t WS_WM_IN = 8 * MiB, WS_WM_OUT = 32 * MiB, WS_WF_IN0 = 40 * MiB, WS_WF_IN1 = 84 * MiB, WS_WF_OUT0 = 128 * MiB, WS_WF_OUT1 = 150 * MiB,
                 WS_WR_IN = 172 * MiB, WS_WG = 188 * MiB, WS_WR_OUT = 190 * MiB;
constexpr size_t WS_HB = 200 * MiB;
constexpr size_t WS_R0 = 264 * MiB, WS_R1 = 328 * MiB, WS_R2 = 392 * MiB, WS_R3 = 456 * MiB;
constexpr size_t WS_CL = 520 * MiB, WS_END = 562 * MiB;
constexpr int LDS_BYTES = 147456;

struct Args { const float* in[17]; float* out; unsigned char* ws; };
typedef const __attribute__((address_space(4))) Args& KA;
enum { I_X = 0, I_NMIX, I_NFFN, I_NFIN, I_MWIN, I_MBIF, I_MHN, I_MWOUT, I_RWIN, I_RCW, I_RCB, I_RGW, I_RGB, I_RAP, I_RWOUT, I_FWIN, I_FWOUT };

__device__ __forceinline__ int launder_v(int v) { asm volatile("" : "+v"(v)); return v; }
__device__ __forceinline__ int launder_s(int v) { asm volatile("" : "+s"(v)); return v; }
__device__ __forceinline__ void lds_wait() { asm volatile("s_waitcnt lgkmcnt(0)" ::: "memory"); }
__device__ __forceinline__ float bf2f(unsigned short v) { return __uint_as_float((unsigned)v << 16); }

#define XB_TMO      128
#define XB_XCNT(j)  (256  + 64 * (j))
#define XB_XSUB(j)  (1280 + 64 * (j))
#define XB_XGEN(j)  (2304 + 64 * (j))
#define XB_TOP      3328
#define XB_TOPGEN   3392
#define XCD_BAR_WORDS 3456
#define XB_SPIN_CAP (1u << 18)

__device__ __forceinline__ unsigned xb_ld(unsigned* p)              { return __hip_atomic_load(p, __ATOMIC_RELAXED, __HIP_MEMORY_SCOPE_AGENT); }
__device__ __forceinline__ unsigned xb_add(unsigned* p, unsigned v) { return __hip_atomic_fetch_add(p, v, __ATOMIC_RELAXED, __HIP_MEMORY_SCOPE_AGENT); }
__device__ __forceinline__ unsigned xb_xcc_id() { return (unsigned)__builtin_amdgcn_s_getreg((3 << 11) | 20) & 0xFu; }
#define XB_SPIN(cond, bar) do { unsigned _sp = 0; while (cond) { __builtin_amdgcn_s_sleep(1); \
    if ((++_sp & 255u) == 0u) { if (xb_ld(&(bar)[XB_TMO])) break; if (_sp > XB_SPIN_CAP) { atomicAdd(&(bar)[XB_TMO], 1u); break; } } } } while (0)

struct XcdBarrier {
    unsigned* bar; unsigned x;
    volatile LAS unsigned* st;
};

__device__ __forceinline__ XcdBarrier xcd_barrier_post(unsigned* bar, volatile LAS unsigned* st) {
    XcdBarrier b; b.bar = bar; b.x = xb_xcc_id(); b.st = st;
    if (threadIdx.x == 0) (void)xb_add(&bar[XB_XCNT(b.x)], 1u);
    return b;
}
__device__ __forceinline__ void xcd_barrier_complete(unsigned* bar, unsigned x, unsigned& nloc, unsigned& nx) {
    const unsigned G = gridDim.x * gridDim.y * gridDim.z;
    unsigned sum, cnt, mine, sp = 0u;
    for (;;) {
        sum = 0u; cnt = 0u; mine = 0u;
#pragma unroll
        for (unsigned j = 0; j < 16; ++j) { const unsigned c = xb_ld(&bar[XB_XCNT(j)]); sum += c; cnt += (c > 0u) ? 1u : 0u; mine = (j == x) ? c : mine; }
        if (sum == G) break;
        __builtin_amdgcn_s_sleep(1);
        if ((++sp & 255u) == 0u) { if (xb_ld(&bar[XB_TMO])) break; if (sp > XB_SPIN_CAP) { atomicAdd(&bar[XB_TMO], 1u); break; } }
    }
    nloc = mine > 0u ? mine : 1u; nx = cnt > 0u ? cnt : 1u;
}

__device__ __forceinline__ void xcd_barrier(const XcdBarrier& b) {
    asm volatile("s_waitcnt vmcnt(0)" ::: "memory");
    __syncthreads();
    if (threadIdx.x == 0) {
        unsigned* bar = b.bar;
        __builtin_amdgcn_s_waitcnt(0);
        unsigned nloc = b.st[0], nx = b.st[1];
        if (nloc == 0u) { xcd_barrier_complete(bar, b.x, nloc, nx); b.st[0] = nloc; b.st[1] = nx; }
        const unsigned old = xb_add(&bar[XB_XSUB(b.x)], 1u);
        const unsigned gen = old / nloc;
        if (old + 1u == (gen + 1u) * nloc) {
            __builtin_amdgcn_fence(__ATOMIC_RELEASE, "agent");
            asm volatile("s_waitcnt vmcnt(0)" ::: "memory");
            const unsigned og = xb_add(&bar[XB_TOP], 1u);
            const unsigned tg = og / nx;
            if (og + 1u == (tg + 1u) * nx) xb_add(&bar[XB_TOPGEN], 1u);
            else XB_SPIN(xb_ld(&bar[XB_TOPGEN]) == tg, bar);
            __builtin_amdgcn_fence(__ATOMIC_ACQUIRE, "agent");
            xb_add(&bar[XB_XGEN(b.x)], 1u);
            asm volatile("s_waitcnt vmcnt(0)" ::: "memory");
        } else {
            XB_SPIN(xb_ld(&bar[XB_XGEN(b.x)]) == gen, bar);
            __builtin_amdgcn_fence(__ATOMIC_ACQUIRE, "agent");
            asm volatile("s_waitcnt vmcnt(0)" ::: "memory");
        }
    }
    __syncthreads();
}

struct CvtJob { const float* W; const float* gk; bf16_t* WT; int K, ldn, N, mode, item; };
struct CvtRegs { float vv[32]; f32x4 g0, g1; };
__device__ __forceinline__ void cvt_load(const CvtJob& j, CvtRegs& R, int lane) {
    const int nblk = j.N >> 5, kb = j.item / nblk, nb = j.item - kb * nblk, k0 = kb * 64, n0 = nb * 32;
    const float* p = j.W + (size_t)(k0 + (lane >> 5)) * j.ldn + n0 + (lane & 31);
#pragma unroll
    for (int i = 0; i < 32; ++i) R.vv[i] = p[(size_t)(2 * i) * j.ldn];
    if (j.gk) { R.g0 = *(const f32x4*)(j.gk + k0 + 8 * (lane & 7)); R.g1 = *(const f32x4*)(j.gk + k0 + 8 * (lane & 7) + 4); }
    else { R.g0 = (f32x4){1.f, 1.f, 1.f, 1.f}; R.g1 = R.g0; }
}
__device__ __forceinline__ void cvt_store(const CvtJob& j, CvtRegs& R, LAS float* scr, int lane) {
    const int nblk = j.N >> 5, kb = j.item / nblk, nb = j.item - kb * nblk, k0 = kb * 64, n0 = nb * 32, mode = j.mode, K = j.K;
#pragma unroll
    for (int i = 0; i < 32; ++i) scr[(2 * i + (lane >> 5)) * 33 + (lane & 31)] = R.vv[i];
    lds_wait();
    const int c = lane & 7;
#pragma unroll
    for (int jj = 0; jj < 4; ++jj) { const int n = (lane >> 3) + 8 * jj, col = n0 + n; const LAS float* sp = scr + (8 * c) * 33 + n;
        float cs = 1.f; int dest = col;
        if (mode == 1) { cs = (col >= 1024 && col < 2048) ? 0.08838834764831845f : 1.f; }
        else if (mode == 2) { const int nn = col >= 5632 ? 1 : 0, ch = col - nn * 5632; dest = 256 * (ch >> 7) + 128 * nn + (ch & 127); }
        else if (mode == 3) { const int nn = col >= 256 ? 1 : 0, ch = col - nn * 256; dest = 256 * (ch >> 7) + 128 * nn + (ch & 127); }
        const f32x4 g0 = R.g0 * cs, g1 = R.g1 * cs;
        u32x4 o; o.x = cvt_pk_bf16(sp[0 * 33] * g0[0], sp[1 * 33] * g0[1]); o.y = cvt_pk_bf16(sp[2 * 33] * g0[2], sp[3 * 33] * g0[3]); o.z = cvt_pk_bf16(sp[4 * 33] * g1[0], sp[5 * 33] * g1[1]); o.w = cvt_pk_bf16(sp[6 * 33] * g1[2], sp[7 * 33] * g1[3]);
        *(u32x4*)(j.WT + (size_t)dest * K + k0 + 8 * c) = o; }
    lds_wait();
}
__device__ __forceinline__ void x_half(KA a, int grp, int half, int lane, f32x4& acc, float& ss) {
    const float* __restrict__ x = a.in[I_X]; const float* __restrict__ W = a.in[I_MWIN]; const float* __restrict__ gmix = a.in[I_NMIX];
    bf16_t* XB = (bf16_t*)(a.ws + WS_HB);
    const int row0 = grp * 16, r = lane & 15, quad = lane >> 4, kbase = half * 1024;
    const float* xr = x + (size_t)(row0 + r) * D_ + quad * 8 + kbase; bf16_t* br = XB + (size_t)(row0 + r) * D_ + quad * 8 + kbase;
    const float* wp = W + (size_t)(kbase + quad * 8) * 6160 + 6144 + r; const float* gp = gmix + kbase + quad * 8;
    acc = (f32x4){0.f, 0.f, 0.f, 0.f}; ss = 0.f;
#pragma unroll 4
    for (int k0 = 0; k0 < 1024; k0 += 32) {
        const f32x4 a0 = *(const f32x4*)(xr + k0), a1 = *(const f32x4*)(xr + k0 + 4);
        ss += (a0[0] * a0[0] + a0[1] * a0[1]) + (a0[2] * a0[2] + a0[3] * a0[3]) + (a1[0] * a1[0] + a1[1] * a1[1]) + (a1[2] * a1[2] + a1[3] * a1[3]);
        u32x4 aw; aw.x = cvt_pk_bf16(a0[0], a0[1]); aw.y = cvt_pk_bf16(a0[2], a0[3]); aw.z = cvt_pk_bf16(a1[0], a1[1]); aw.w = cvt_pk_bf16(a1[2], a1[3]);
        *(u32x4*)(br + k0) = aw;
        const f32x4 g0 = *(const f32x4*)(gp + k0), g1 = *(const f32x4*)(gp + k0 + 4);
        const float* w = wp + (size_t)k0 * 6160;
        u32x4 bw; bw.x = cvt_pk_bf16(w[0] * g0[0], w[6160] * g0[1]); bw.y = cvt_pk_bf16(w[2 * 6160] * g0[2], w[3 * 6160] * g0[3]);
        bw.z = cvt_pk_bf16(w[4 * 6160] * g1[0], w[5 * 6160] * g1[1]); bw.w = cvt_pk_bf16(w[6 * 6160] * g1[2], w[7 * 6160] * g1[3]);
        acc = __builtin_amdgcn_mfma_f32_16x16x32_bf16(__builtin_bit_cast(bf16x8, aw), __builtin_bit_cast(bf16x8, bw), acc, 0, 0, 0);
    }
}
__device__ __forceinline__ void x_finish(KA a, int grp, int lane, f32x4 acc, float ss) {
    float* ssq0 = (float*)(a.ws + WS_SSQ);
    const int row0 = grp * 16, r = lane & 15, quad = lane >> 4;
    ss += shx(ss, 16, lane); ss += shx(ss, 32, lane);
    { const f32x4 z = {0.f, 0.f, 0.f, 0.f}; f32x4 first = z; if (quad == 0) first[0] = ss; float* sp = ssq0 + (size_t)(row0 + r) * 32 + quad * 8; *(f32x4*)sp = first; *(f32x4*)(sp + 4) = z; }
    const int n = r; const float bias = a.in[I_MBIF][n];
    float* IG = (float*)(a.ws + WS_IG); float* LF = (float*)(a.ws + WS_LF);
#pragma unroll
    for (int rr = 0; rr < 4; ++rr) { const int row = 4 * quad + rr; const float srow = shi(ss, row); const float rs = rsqrtf(srow * (1.0f / 2048.0f) + RMS_EPS);
        const float pre = acc[rr] * rs + bias; const int grow = row0 + row, b = grow >> 13, t = grow & 8191, h = n & 7; const size_t idx = (size_t)(b * 8 + h) * S_ + t;
        if (n < 8) IG[idx] = pre; else LF[idx] = logsigmoidf_(pre); }
}
__device__ __forceinline__ bool cvt_decode(KA a, int r, CvtJob& j) {
    constexpr int I0 = 32 * 192, I1 = 32 * 64, I2 = 32 * 352, I4 = 88 * 64, I6 = 32 * 128, I7 = 8 * 64, I8 = 32 * 64;
    j.gk = nullptr; j.mode = 0; j.K = 2048; j.ldn = 2048; j.N = 2048;
    if (r < I0) { j.W = a.in[I_MWIN]; j.ldn = 6160; j.N = 6144; j.WT = (bf16_t*)(a.ws + WS_WM_IN); j.mode = 1; j.gk = a.in[I_NMIX]; j.item = r; return true; } r -= I0;
    if (r < I1) { j.W = a.in[I_MWOUT]; j.WT = (bf16_t*)(a.ws + WS_WM_OUT); j.item = r; return true; } r -= I1;
    if (r < I2) { j.W = a.in[I_FWIN]; j.ldn = 11264; j.N = 11264; j.WT = (bf16_t*)(a.ws + WS_WF_IN0); j.mode = 2; j.gk = a.in[I_NFFN]; j.item = r; return true; } r -= I2;
    if (r < I2) { j.W = a.in[I_FWIN] + (size_t)2048 * 11264; j.ldn = 11264; j.N = 11264; j.WT = (bf16_t*)(a.ws + WS_WF_IN1); j.mode = 2; j.gk = a.in[I_NFFN] + 2048; j.item = r; return true; } r -= I2;
    if (r < I4) { j.W = a.in[I_FWOUT]; j.K = 5632; j.WT = (bf16_t*)(a.ws + WS_WF_OUT0); j.item = r; return true; } r -= I4;
    if (r < I4) { j.W = a.in[I_FWOUT] + (size_t)5632 * 2048; j.K = 5632; j.WT = (bf16_t*)(a.ws + WS_WF_OUT1); j.item = r; return true; } r -= I4;
    if (r < I6) { j.W = a.in[I_RWIN]; j.ldn = 4096; j.N = 4096; j.WT = (bf16_t*)(a.ws + WS_WR_IN); j.gk = a.in[I_NMIX] + 2048; j.item = r; return true; } r -= I6;
    if (r < I7) { const int blk = r >> 6; j.W = a.in[I_RGW] + (size_t)blk * 256 * 512; j.K = 256; j.ldn = 512; j.N = 512; j.WT = (bf16_t*)(a.ws + WS_WG) + (size_t)blk * 512 * 256; j.mode = 3; j.item = r & 63; return true; } r -= I7;
    if (r < I8) { j.W = a.in[I_RWOUT]; j.WT = (bf16_t*)(a.ws + WS_WR_OUT); j.item = r; return true; }
    return false;
}
__device__ __forceinline__ void prologue(KA a, LAS unsigned char* lds, int bid, int G, int lane, int wave) {
    LAS float* scr = (LAS float*)(lds + wave * 16384);
    for (int g0 = bid * 4; g0 < M_ / 16; g0 += G * 4) {
        const int grp = g0 + (wave & 3); f32x4 acc; float ss;
        x_half(a, grp, wave >> 2, lane, acc, ss);
        LAS float* xs = (LAS float*)(lds + (wave & 3) * 16384 + 12288) + lane * 5;
        if (wave >= 4) { xs[0] = acc[0]; xs[1] = acc[1]; xs[2] = acc[2]; xs[3] = acc[3]; xs[4] = ss; }
        __syncthreads();
        if (wave < 4) { acc[0] += xs[0]; acc[1] += xs[1]; acc[2] += xs[2]; acc[3] += xs[3]; ss += xs[4]; x_finish(a, grp, lane, acc, ss); }
        __syncthreads();
    }
    const int gw = wave * G + bid, NGW = G * 8;
    CvtJob j0, j1; CvtRegs r0, r1;
    int it = gw; bool ok0 = cvt_decode(a, it, j0), ok1;
    if (ok0) cvt_load(j0, r0, lane);
    while (ok0) {
        ok1 = cvt_decode(a, it + NGW, j1); if (ok1) cvt_load(j1, r1, lane);
        cvt_store(j0, r0, scr, lane);
        if (!ok1) break;
        it += 2 * NGW; ok0 = cvt_decode(a, it, j0); if (ok0) cvt_load(j0, r0, lane);
        cvt_store(j1, r1, scr, lane);
    }
}

__device__ __forceinline__ s16x4 tr16(const LAS short* p) { return __builtin_amdgcn_ds_read_tr16_b64_v4i16((LAS s16x4*)p); }
__device__ __forceinline__ bf16x8 tr_frag(const LAS short* T, int pitch, int krow0, int col0, int lane) {
    const int g = lane >> 4, q = (lane & 15) >> 2, p = lane & 3;
    const LAS short* a0 = T + (krow0 + 8 * g + q) * pitch + col0 + 4 * p;
    const s16x4 lo = tr16(a0), hi = tr16(a0 + 4 * pitch);
    bf16x8 r; r[0] = lo[0]; r[1] = lo[1]; r[2] = lo[2]; r[3] = lo[3]; r[4] = hi[0]; r[5] = hi[1]; r[6] = hi[2]; r[7] = hi[3]; return r;
}
constexpr int PQ = 136, PV = 264, PP = 72;
constexpr int L_Q = 0, L_K = 17408, L_KW = 34816, L_V = 52224, L_P = 86016, L_F = 95232;
constexpr int L_G = 98816;
constexpr int F_B = 0, F_PM = 64, F_SI = 128, F_HD = 192, F_N = 256, F_SSQ = 384;

struct ChunkGates { float a, pm, b, wk, decay, m_new, b_last; };
struct GateScan { float a, b, cm, b_last, cm_last; };
__device__ __forceinline__ GateScan gate_scan(float ig, float lf, int lane) {
    GateScan g; float b = lf;
#pragma unroll
    for (int o = 1; o < 64; o <<= 1) { const float t = shi(b, lane >= o ? lane - o : lane); if (lane >= o) b += t; }
    const float av = ig - b; float cm = av;
#pragma unroll
    for (int o = 1; o < 64; o <<= 1) { const float t = shi(cm, lane >= o ? lane - o : lane); if (lane >= o) cm = fmaxf(cm, t); }
    g.a = av; g.b = b; g.cm = cm; g.b_last = shi(b, 63); g.cm_last = shi(cm, 63); return g;
}
__device__ __forceinline__ ChunkGates gate_finish(const GateScan& s, float m) {
    ChunkGates g; g.a = s.a; g.b = s.b; g.pm = fmaxf(m, s.cm); g.b_last = s.b_last;
    const float pml = fmaxf(m, s.cm_last);
    g.wk = __expf(s.a - pml); g.decay = __expf(m - pml); g.m_new = s.b_last + pml; return g;
}
__device__ __forceinline__ void item_gate_scans(const float* IG, const float* LF, size_t gbase, LAS unsigned char* lds, int lane, int wave) {
    LAS float* gq = (LAS float*)(lds + L_G);
    const GateScan s1 = gate_scan(IG[gbase + wave * 64 + lane], LF[gbase + wave * 64 + lane], lane);
    gq[wave * 64 + lane] = s1.a; gq[512 + wave * 64 + lane] = s1.b; gq[1024 + wave * 64 + lane] = s1.cm;
    if (lane == 0) { gq[1536 + 2 * wave] = s1.b_last; gq[1536 + 2 * wave + 1] = s1.cm_last; }
}
__device__ __forceinline__ GateScan chunk_scan_from_lds(LAS unsigned char* lds, int ch, int lane) {
    const LAS float* gq = (const LAS float*)(lds + L_G); GateScan g;
    g.a = gq[ch * 64 + lane]; g.b = gq[512 + ch * 64 + lane]; g.cm = gq[1024 + ch * 64 + lane]; g.b_last = gq[1536 + 2 * ch]; g.cm_last = gq[1536 + 2 * ch + 1]; return g;
}
__device__ __forceinline__ u32x4 scale_bf16x8(u32x4 v, float w) {
    u32x4 o; o.x = cvt_pk_bf16(bf_lo(v.x) * w, bf_hi(v.x) * w); o.y = cvt_pk_bf16(bf_lo(v.y) * w, bf_hi(v.y) * w); o.z = cvt_pk_bf16(bf_lo(v.z) * w, bf_hi(v.z) * w); o.w = cvt_pk_bf16(bf_lo(v.w) * w, bf_hi(v.w) * w); return o;
}
__device__ __forceinline__ void state_update(f32x4 (&C)[8][2], const bf16x8 (&Vf)[2][2], const LAS short* KWs, float decay, int lane) {
#pragma unroll
    for (int db = 0; db < 8; ++db) {
#pragma unroll
        for (int vb = 0; vb < 2; ++vb) C[db][vb] = C[db][vb] * decay;
#pragma unroll
        for (int ks = 0; ks < 2; ++ks) { const bf16x8 A = tr_frag(KWs, PQ, 32 * ks, 16 * db, lane);
#pragma unroll
            for (int vb = 0; vb < 2; ++vb) C[db][vb] = __builtin_amdgcn_mfma_f32_16x16x32_bf16(A, Vf[vb][ks], C[db][vb], 0, 0, 0); } }
}
__device__ __forceinline__ void mlstm_local(KA a, LAS unsigned char* lds, int tid, int lane, int wave) {
    LAS short* KWs = (LAS short*)(lds + L_KW); LAS short* Vs = (LAS short*)(lds + L_V); LAS float* fv = (LAS float*)(lds + L_F);
    const bf16_t* Kg = (const bf16_t*)(a.ws + WS_R0 + 32 * MiB); const bf16_t* Vg = (const bf16_t*)(a.ws + WS_R1);
    const float* IG = (const float*)(a.ws + WS_IG); const float* LF = (const float*)(a.ws + WS_LF);
    for (int item = blockIdx.x; item < 256; item += gridDim.x) {
        const int bh = item >> 4, sc = item & 15, b = bh >> 3, h = bh & 7;
        f32x4 C[8][2];
#pragma unroll
        for (int db = 0; db < 8; ++db) { C[db][0] = (f32x4){0.f, 0.f, 0.f, 0.f}; C[db][1] = (f32x4){0.f, 0.f, 0.f, 0.f}; }
        float m = -1e30f, btot = 0.f;
        __syncthreads();
        if (tid < 128) fv[F_N + tid] = 0.f;
        item_gate_scans(IG, LF, (size_t)bh * S_ + sc * 512, lds, lane, wave);
        u32x4 kreg[2], vreg[4];
        { const size_t row0 = (size_t)b * S_ + sc * 512;
#pragma unroll
          for (int i = 0; i < 2; ++i) { const int p = tid + 512 * i, r = p >> 4, pc = p & 15; kreg[i] = *(const u32x4*)(Kg + (row0 + r) * 1024 + h * 128 + pc * 8); }
#pragma unroll
          for (int i = 0; i < 4; ++i) { const int p = tid + 512 * i, r = p >> 5, pc = p & 31; vreg[i] = *(const u32x4*)(Vg + (row0 + r) * 2048 + h * 256 + pc * 8); }
        }
        __syncthreads();
        for (int ch = 0; ch < 8; ++ch) {
            const ChunkGates g = gate_finish(chunk_scan_from_lds(lds, ch, lane), m);
            __syncthreads();
#pragma unroll
            for (int i = 0; i < 2; ++i) { const int p = tid + 512 * i, r = p >> 4, pc = p & 15; *(LAS u32x4*)(KWs + r * PQ + pc * 8) = scale_bf16x8(kreg[i], shi(g.wk, r)); }
#pragma unroll
            for (int i = 0; i < 4; ++i) { const int p = tid + 512 * i, r = p >> 5, pc = p & 31; *(LAS u32x4*)(Vs + r * PV + pc * 8) = vreg[i]; }
            if (ch < 7) { const int t1 = sc * 512 + (ch + 1) * 64; const size_t row1 = (size_t)b * S_ + t1;
#pragma unroll
                for (int i = 0; i < 2; ++i) { const int p = tid + 512 * i, r = p >> 4, pc = p & 15; kreg[i] = *(const u32x4*)(Kg + (row1 + r) * 1024 + h * 128 + pc * 8); }
#pragma unroll
                for (int i = 0; i < 4; ++i) { const int p = tid + 512 * i, r = p >> 5, pc = p & 31; vreg[i] = *(const u32x4*)(Vg + (row1 + r) * 2048 + h * 256 + pc * 8); } }
            __syncthreads();
            bf16x8 Vf[2][2];
#pragma unroll
            for (int vb = 0; vb < 2; ++vb)
#pragma unroll
                for (int ks = 0; ks < 2; ++ks) Vf[vb][ks] = tr_frag(Vs, PV, 32 * ks, 32 * wave + 16 * vb, lane);
            state_update(C, Vf, KWs, g.decay, lane);
            if (tid < 128) { float s = 0.f;
#pragma unroll 8
                for (int s_ = 0; s_ < 64; ++s_) s += bf2f((unsigned short)KWs[s_ * PQ + tid]);
                fv[F_N + tid] = g.decay * fv[F_N + tid] + s; }
            m = g.m_new; btot += g.b_last;
        }
        float* CL = (float*)(a.ws + WS_CL) + (size_t)item * 32768;
#pragma unroll
        for (int db = 0; db < 8; ++db)
#pragma unroll
            for (int vb = 0; vb < 2; ++vb)
#pragma unroll
                for (int r = 0; r < 4; ++r) CL[((db * 2 + vb) * 4 + r) * 512 + tid] = C[db][vb][r];
        if (tid < 128) ((float*)(a.ws + WS_NL))[item * 128 + tid] = fv[F_N + tid];
        if (tid == 0) { ((float*)(a.ws + WS_ML))[item] = m; ((float*)(a.ws + WS_BT))[item] = btot; }
    }
}
__device__ __forceinline__ void mlstm_scan(KA a, int gtid, int nthr) {
    float* CL = (float*)(a.ws + WS_CL); float* NL = (float*)(a.ws + WS_NL);
    const float* ML = (const float*)(a.ws + WS_ML); const float* BT = (const float*)(a.ws + WS_BT); float* MS = (float*)(a.ws + WS_MS);
    for (int e = gtid; e < 16 * 32896; e += nthr) { const int bh = e / 32896, idx = e - bh * 32896; float c = 0.f, m = 0.f;
        float* p0 = idx < 32768 ? CL + (size_t)(bh * 16) * 32768 + idx : NL + (bh * 16) * 128 + (idx - 32768); const size_t pstep = idx < 32768 ? 32768 : 128;
        float loc[16], ml[16], bt[16];
#pragma unroll
        for (int j = 0; j < 16; ++j) { loc[j] = p0[j * pstep]; ml[j] = ML[bh * 16 + j]; bt[j] = BT[bh * 16 + j]; }
#pragma unroll
        for (int j = 0; j < 16; ++j) { p0[j * pstep] = c; if (idx == 0) MS[bh * 16 + j] = m;
            const float mn = fmaxf(bt[j] + m, ml[j]); c = __expf(bt[j] + m - mn) * c + __expf(ml[j] - mn) * loc[j]; m = mn; } }
}
__device__ __forceinline__ void mlstm_out(KA a, LAS unsigned char* lds, int tid, int lane_in, int wave) {
    LAS short* Qs = (LAS short*)(lds + L_Q); LAS short* Ks = (LAS short*)(lds + L_K); LAS short* KWs = (LAS short*)(lds + L_KW); LAS short* Vs = (LAS short*)(lds + L_V);
    LAS short* Ps = (LAS short*)(lds + L_P); LAS float* fv = (LAS float*)(lds + L_F);
    const bf16_t* Qg = (const bf16_t*)(a.ws + WS_R0); const bf16_t* Kg = (const bf16_t*)(a.ws + WS_R0 + 32 * MiB); const bf16_t* Vg = (const bf16_t*)(a.ws + WS_R1);
    const bf16_t* Og = (const bf16_t*)(a.ws + WS_R2); bf16_t* HG = (bf16_t*)(a.ws + WS_R3);
    const float* IG = (const float*)(a.ws + WS_IG); const float* LF = (const float*)(a.ws + WS_LF); const float* hnorm = a.in[I_MHN];
    for (int item = blockIdx.x; item < 256; item += gridDim.x) {
        const int bh = item >> 4, sc = item & 15, b = bh >> 3, h = bh & 7;
        f32x4 C[8][2];
        { const float* CL = (const float*)(a.ws + WS_CL) + (size_t)item * 32768;
#pragma unroll
          for (int db = 0; db < 8; ++db)
#pragma unroll
            for (int vb = 0; vb < 2; ++vb)
#pragma unroll
                for (int r = 0; r < 4; ++r) C[db][vb][r] = CL[((db * 2 + vb) * 4 + r) * 512 + tid]; }
        float m = ((const float*)(a.ws + WS_MS))[item];
        __syncthreads();
        if (tid < 128) fv[F_N + tid] = ((const float*)(a.ws + WS_NL))[item * 128 + tid];
        item_gate_scans(IG, LF, (size_t)bh * S_ + sc * 512, lds, lane_in, wave);
        u32x4 qreg[2], kreg[2], vreg[4]; u32x2 ocur[2][4];
        { const int lane = lane_in, tid = wave * 64 + lane; const size_t row0 = (size_t)b * S_ + sc * 512;
#pragma unroll
          for (int i = 0; i < 2; ++i) { const int p = tid + 512 * i, r = p >> 4, pc = p & 15; qreg[i] = *(const u32x4*)(Qg + (row0 + r) * 1024 + h * 128 + pc * 8); kreg[i] = *(const u32x4*)(Kg + (row0 + r) * 1024 + h * 128 + pc * 8); }
#pragma unroll
          for (int i = 0; i < 4; ++i) { const int p = tid + 512 * i, r = p >> 5, pc = p & 31; vreg[i] = *(const u32x4*)(Vg + (row0 + r) * 2048 + h * 256 + pc * 8); }
#pragma unroll
          for (int tb = 0; tb < 4; ++tb)
#pragma unroll
            for (int vb = 0; vb < 2; ++vb) ocur[vb][tb] = *(const u32x2*)(Og + (row0 + 16 * tb + (lane & 15)) * 2048 + h * 256 + 32 * wave + 16 * vb + 4 * (lane >> 4)); }
        __syncthreads();
        f32x4 hnr[2];
#pragma unroll
        for (int vb = 0; vb < 2; ++vb) hnr[vb] = *(const f32x4*)(hnorm + h * 256 + 32 * wave + 16 * vb + 4 * (lane_in >> 4));
        for (int ch = 0; ch < 8; ++ch) {
            const int lane = launder_v(lane_in), tid = wave * 64 + lane, l15 = lane & 15, g4 = lane >> 4;
            const int t0 = sc * 512 + ch * 64; const size_t row0 = (size_t)b * S_ + t0;
            const ChunkGates g = gate_finish(chunk_scan_from_lds(lds, ch, lane), m);
            const float si = __expf(m - g.pm);
            if (wave == 0) { fv[F_B + lane] = g.b; fv[F_PM + lane] = g.pm; fv[F_SI + lane] = si; }
#pragma unroll
            for (int i = 0; i < 2; ++i) { const int p = tid + 512 * i, r = p >> 4, pc = p & 15;
                *(LAS u32x4*)(Qs + r * PQ + pc * 8) = qreg[i]; *(LAS u32x4*)(Ks + r * PQ + pc * 8) = kreg[i]; *(LAS u32x4*)(KWs + r * PQ + pc * 8) = scale_bf16x8(kreg[i], shi(g.wk, r)); }
#pragma unroll
            for (int i = 0; i < 4; ++i) { const int p = tid + 512 * i, r = p >> 5, pc = p & 31; *(LAS u32x4*)(Vs + r * PV + pc * 8) = vreg[i]; }
            if (ch < 7) { const size_t row1 = row0 + 64;
#pragma unroll
                for (int i = 0; i < 2; ++i) { const int p = tid + 512 * i, r = p >> 4, pc = p & 15; qreg[i] = *(const u32x4*)(Qg + (row1 + r) * 1024 + h * 128 + pc * 8); kreg[i] = *(const u32x4*)(Kg + (row1 + r) * 1024 + h * 128 + pc * 8); }
#pragma unroll
                for (int i = 0; i < 4; ++i) { const int p = tid + 512 * i, r = p >> 5, pc = p & 31; vreg[i] = *(const u32x4*)(Vg + (row1 + r) * 2048 + h * 256 + pc * 8); }
 }
            __syncthreads();
            { const int tb = wave >> 1, t = 16 * tb + l15; const float pm_t = shi(g.pm, t);
#pragma unroll
              for (int xx = 0; xx < 2; ++xx) { const int sb = 2 * (wave & 1) + xx; f32x4 sacc = {0.f, 0.f, 0.f, 0.f};
                if (sb <= tb) {
#pragma unroll
                    for (int ks = 0; ks < 4; ++ks) { const bf16x8 A = *(const LAS bf16x8*)(Ks + (16 * sb + l15) * PQ + 32 * ks + 8 * g4), B = *(const LAS bf16x8*)(Qs + t * PQ + 32 * ks + 8 * g4);
                        sacc = __builtin_amdgcn_mfma_f32_16x16x32_bf16(A, B, sacc, 0, 0, 0); } }
                float p[4];
#pragma unroll
                for (int r = 0; r < 4; ++r) { const int s = 16 * sb + 4 * g4 + r; const float a_s = shi(g.a, s); p[r] = (s <= t) ? sacc[r] * __expf(a_s - pm_t) : 0.f; }
                u32x2 w; w.x = cvt_pk_bf16(p[0], p[1]); w.y = cvt_pk_bf16(p[2], p[3]); *(LAS u32x2*)(Ps + t * PP + 16 * sb + 4 * g4) = w; } }
            __syncthreads();
            f32x4 acc[2][4];
#pragma unroll
            for (int vb = 0; vb < 2; ++vb)
#pragma unroll
                for (int tb = 0; tb < 4; ++tb) acc[vb][tb] = (f32x4){0.f, 0.f, 0.f, 0.f};
#pragma unroll
            for (int ks = 0; ks < 4; ++ks) { bf16x8 Cf[2];
#pragma unroll
                for (int vb = 0; vb < 2; ++vb) { u32x4 w; const f32x4 c0 = C[2 * ks][vb], c1 = C[2 * ks + 1][vb];
                    w.x = cvt_pk_bf16(c0[0], c0[1]); w.y = cvt_pk_bf16(c0[2], c0[3]); w.z = cvt_pk_bf16(c1[0], c1[1]); w.w = cvt_pk_bf16(c1[2], c1[3]); Cf[vb] = __builtin_bit_cast(bf16x8, w); }
#pragma unroll
                for (int tb = 0; tb < 4; ++tb) { const LAS short* qp = Qs + (16 * tb + l15) * PQ + 32 * ks + 4 * g4; const u32x2 q0 = *(const LAS u32x2*)qp, q1 = *(const LAS u32x2*)(qp + 16);
                    u32x4 qw; qw.x = q0.x; qw.y = q0.y; qw.z = q1.x; qw.w = q1.y; const bf16x8 Qf = __builtin_bit_cast(bf16x8, qw);
#pragma unroll
                    for (int vb = 0; vb < 2; ++vb) acc[vb][tb] = __builtin_amdgcn_mfma_f32_16x16x32_bf16(Cf[vb], Qf, acc[vb][tb], 0, 0, 0); } }
#pragma unroll
            for (int tb = 0; tb < 4; ++tb) { const float si_t = shi(si, 16 * tb + l15); acc[0][tb] = acc[0][tb] * si_t; acc[1][tb] = acc[1][tb] * si_t; }
            bf16x8 Vf[2][2];
#pragma unroll
            for (int vb = 0; vb < 2; ++vb)
#pragma unroll
                for (int ks = 0; ks < 2; ++ks) Vf[vb][ks] = tr_frag(Vs, PV, 32 * ks, 32 * wave + 16 * vb, lane);
#pragma unroll
            for (int ks = 0; ks < 2; ++ks)
#pragma unroll
                for (int tb = 0; tb < 4; ++tb) { const bf16x8 Pf = *(const LAS bf16x8*)(Ps + (16 * tb + l15) * PP + 32 * ks + 8 * g4);
#pragma unroll
                    for (int vb = 0; vb < 2; ++vb) acc[vb][tb] = __builtin_amdgcn_mfma_f32_16x16x32_bf16(Vf[vb][ks], Pf, acc[vb][tb], 0, 0, 0); }
            { const int t = tid >> 3, part = tid & 7; const u32x4 pw = *(const LAS u32x4*)(Ps + t * PP + 8 * part);
              const float psum = (bf_lo(pw.x) + bf_hi(pw.x)) + (bf_lo(pw.y) + bf_hi(pw.y)) + (bf_lo(pw.z) + bf_hi(pw.z)) + (bf_lo(pw.w) + bf_hi(pw.w));
              const u32x4 qa = *(const LAS u32x4*)(Qs + t * PQ + 16 * part), qb = *(const LAS u32x4*)(Qs + t * PQ + 16 * part + 8); const LAS float* nv = fv + F_N + 16 * part;
              float qn = bf_lo(qa.x) * nv[0] + bf_hi(qa.x) * nv[1] + bf_lo(qa.y) * nv[2] + bf_hi(qa.y) * nv[3] + bf_lo(qa.z) * nv[4] + bf_hi(qa.z) * nv[5] + bf_lo(qa.w) * nv[6] + bf_hi(qa.w) * nv[7]
                       + bf_lo(qb.x) * nv[8] + bf_hi(qb.x) * nv[9] + bf_lo(qb.y) * nv[10] + bf_hi(qb.y) * nv[11] + bf_lo(qb.z) * nv[12] + bf_hi(qb.z) * nv[13] + bf_lo(qb.w) * nv[14] + bf_hi(qb.w) * nv[15];
              float den = psum + fv[F_SI + t] * qn; den += shx(den, 1, lane); den += shx(den, 2, lane); den += shx(den, 4, lane);
              if (part == 0) fv[F_HD + t] = __builtin_amdgcn_rcpf(fmaxf(fabsf(den), __expf(-(fv[F_B + t] + fv[F_PM + t])))); }
            __syncthreads();
#pragma unroll
            for (int tb = 0; tb < 4; ++tb) { const float hd = fv[F_HD + 16 * tb + l15]; float ss = 0.f;
#pragma unroll
                for (int vb = 0; vb < 2; ++vb) { acc[vb][tb] = acc[vb][tb] * hd; const f32x4 v = acc[vb][tb]; ss += (v[0] * v[0] + v[1] * v[1]) + (v[2] * v[2] + v[3] * v[3]); }
                ss += shx(ss, 16, lane); ss += shx(ss, 32, lane);
                if (lane < 16) fv[F_SSQ + wave * 64 + 16 * tb + lane] = ss; }
            if (tid < 128) { float s = 0.f;
#pragma unroll 8
                for (int s_ = 0; s_ < 64; ++s_) s += bf2f((unsigned short)KWs[s_ * PQ + tid]);
                fv[F_N + tid] = g.decay * fv[F_N + tid] + s; }
            state_update(C, Vf, KWs, g.decay, lane);
            __syncthreads();
#pragma unroll
            for (int tb = 0; tb < 4; ++tb) { const int t = 16 * tb + l15; float tot = 0.f;
#pragma unroll
                for (int w = 0; w < 8; ++w) tot += fv[F_SSQ + w * 64 + t];
                const float rs = rsqrtf(tot * (1.0f / 256.0f) + RMS_EPS);
#pragma unroll
                for (int vb = 0; vb < 2; ++vb) { const int col = h * 256 + 32 * wave + 16 * vb + 4 * g4; const f32x4 hn = hnr[vb];
                    const u32x2 ow = ocur[vb][tb]; const f32x4 v = acc[vb][tb];
                    u32x2 w; w.x = cvt_pk_bf16(v[0] * rs * hn[0] * bf_lo(ow.x), v[1] * rs * hn[1] * bf_hi(ow.x)); w.y = cvt_pk_bf16(v[2] * rs * hn[2] * bf_lo(ow.y), v[3] * rs * hn[3] * bf_hi(ow.y));
                    *(u32x2*)(HG + (row0 + t) * 2048 + col) = w; } }
            m = g.m_new;
            if (ch < 7) {
#pragma unroll
                for (int tb = 0; tb < 4; ++tb)
#pragma unroll
                    for (int vb = 0; vb < 2; ++vb) ocur[vb][tb] = *(const u32x2*)(Og + (row0 + 64 + 16 * tb + l15) * 2048 + h * 256 + 32 * wave + 16 * vb + 4 * g4); }
        }
    }
}

__device__ __forceinline__ void rg_conv(KA a, int gtid, int nthr) {
    const bf16_t* REC = (const bf16_t*)(a.ws + WS_R1); bf16_t* XC = (bf16_t*)(a.ws + WS_R2); const float* cw = a.in[I_RCW]; const float* cb = a.in[I_RCB];
    for (int e = gtid; e < (M_ / 16) * 256; e += nthr) { const int rg = e >> 8, c0 = (e & 255) * 8, row0 = rg * 16, t0 = row0 & (S_ - 1);
        u32x4 v[19];
#pragma unroll
        for (int i = 0; i < 19; ++i) { if (t0 + i - 3 >= 0) v[i] = *(const u32x4*)(REC + (size_t)(row0 + i - 3) * 2048 + c0); else v[i] = (u32x4){0u, 0u, 0u, 0u}; }
        f32x4 w0[4], w1[4];
#pragma unroll
        for (int j = 0; j < 4; ++j) { w0[j] = *(const f32x4*)(cw + j * 2048 + c0); w1[j] = *(const f32x4*)(cw + j * 2048 + c0 + 4); }
        const f32x4 b0 = *(const f32x4*)(cb + c0), b1 = *(const f32x4*)(cb + c0 + 4);
#pragma unroll
        for (int r = 0; r < 16; ++r) { f32x4 o0 = b0, o1 = b1;
#pragma unroll
            for (int j = 0; j < 4; ++j) { const u32x4 x = v[r + j];
                o0[0] += w0[j][0] * bf_lo(x.x); o0[1] += w0[j][1] * bf_hi(x.x); o0[2] += w0[j][2] * bf_lo(x.y); o0[3] += w0[j][3] * bf_hi(x.y);
                o1[0] += w1[j][0] * bf_lo(x.z); o1[1] += w1[j][1] * bf_hi(x.z); o1[2] += w1[j][2] * bf_lo(x.w); o1[3] += w1[j][3] * bf_hi(x.w); }
            u32x4 w; w.x = cvt_pk_bf16(o0[0], o0[1]); w.y = cvt_pk_bf16(o0[2], o0[3]); w.z = cvt_pk_bf16(o1[0], o1[1]); w.w = cvt_pk_bf16(o1[2], o1[3]);
            *(u32x4*)(XC + (size_t)(row0 + r) * 2048 + c0) = w; } }
}
__device__ __forceinline__ void rg_scan1(KA a, int gtid, int nthr) {
    const bf16_t* LA = (const bf16_t*)(a.ws + WS_R3); const bf16_t* U = (const bf16_t*)(a.ws + WS_R1); float* SP = (float*)(a.ws + WS_SP); float* SH = (float*)(a.ws + WS_SH);
    for (int it = gtid; it < 131072; it += nthr) { const int c = (it & 1023) * 2, j = (it >> 10) & 63, b = it >> 16; const size_t base = ((size_t)b * S_ + j * 128) * 2048 + c;
        float h0 = 0.f, h1 = 0.f, s0 = 0.f, s1 = 0.f; unsigned la[2][16], uu[2][16];
#pragma unroll
        for (int t = 0; t < 16; ++t) { la[0][t] = *(const unsigned*)(LA + base + (size_t)t * 2048); uu[0][t] = *(const unsigned*)(U + base + (size_t)t * 2048); }
#pragma unroll
        for (int bt = 0; bt < 8; ++bt) { const int cur = bt & 1, nxt = cur ^ 1;
            if (bt < 7) {
#pragma unroll
                for (int t = 0; t < 16; ++t) { const size_t off = base + (size_t)((bt + 1) * 16 + t) * 2048; la[nxt][t] = *(const unsigned*)(LA + off); uu[nxt][t] = *(const unsigned*)(U + off); } }
#pragma unroll
            for (int t = 0; t < 16; ++t) { const float l0 = bf_lo(la[cur][t]), l1 = bf_hi(la[cur][t]); s0 += l0; s1 += l1; h0 = __expf(l0) * h0 + bf_lo(uu[cur][t]); h1 = __expf(l1) * h1 + bf_hi(uu[cur][t]); } }
        const size_t o = ((size_t)b * 64 + j) * 2048 + c; SP[o] = s0; SP[o + 1] = s1; SH[o] = h0; SH[o + 1] = h1; }
}
__device__ __forceinline__ void rg_scan2(KA a, int gtid, int nthr) {
    const bf16_t* LA = (const bf16_t*)(a.ws + WS_R3); const bf16_t* U = (const bf16_t*)(a.ws + WS_R1); const bf16_t* GG = (const bf16_t*)(a.ws + WS_R0); bf16_t* YB = (bf16_t*)(a.ws + WS_R2);
    const float* SP = (const float*)(a.ws + WS_SP); const float* SH = (const float*)(a.ws + WS_SH);
    for (int it = gtid; it < 131072; it += nthr) { const int c = (it & 1023) * 2, j = (it >> 10) & 63, b = it >> 16; const size_t base = ((size_t)b * S_ + j * 128) * 2048 + c;
        unsigned la[2][16], uu[2][16], gg[2][16];
#pragma unroll
        for (int t = 0; t < 16; ++t) { const size_t off = base + (size_t)t * 2048; la[0][t] = *(const unsigned*)(LA + off); uu[0][t] = *(const unsigned*)(U + off); gg[0][t] = *(const unsigned*)(GG + off); }
        float h0 = 0.f, h1 = 0.f;
        for (int j0 = 0; j0 < j; j0 += 8) { f32x2_ sp[8], sh[8];
#pragma unroll
            for (int q = 0; q < 8; ++q) { const size_t o = ((size_t)b * 64 + (j0 + q < j ? j0 + q : 0)) * 2048 + c; sp[q] = *(const f32x2_*)(SP + o); sh[q] = *(const f32x2_*)(SH + o); }
#pragma unroll
            for (int q = 0; q < 8; ++q) if (j0 + q < j) { h0 = __expf(sp[q].x) * h0 + sh[q].x; h1 = __expf(sp[q].y) * h1 + sh[q].y; } }
#pragma unroll
        for (int bt = 0; bt < 8; ++bt) { const int cur = bt & 1, nxt = cur ^ 1;
            if (bt < 7) {
#pragma unroll
                for (int t = 0; t < 16; ++t) { const size_t off = base + (size_t)((bt + 1) * 16 + t) * 2048; la[nxt][t] = *(const unsigned*)(LA + off); uu[nxt][t] = *(const unsigned*)(U + off); gg[nxt][t] = *(const unsigned*)(GG + off); } }
#pragma unroll
            for (int t = 0; t < 16; ++t) { const size_t off = base + (size_t)(bt * 16 + t) * 2048;
                h0 = __expf(bf_lo(la[cur][t])) * h0 + bf_lo(uu[cur][t]); h1 = __expf(bf_hi(la[cur][t])) * h1 + bf_hi(uu[cur][t]);
                *(unsigned*)(YB + off) = cvt_pk_bf16(bf_lo(gg[cur][t]) * h0, bf_hi(gg[cur][t]) * h1); } }
    }
}
__device__ __forceinline__ void final_norm(KA a, int gw, int NGW, int lane) {
    const float* ssqp = (const float*)(a.ws + WS_SSQ) + 4 * SSQ_STAGE; const float* gf = a.in[I_NFIN]; const bf16_t* HBp = (const bf16_t*)(a.ws + WS_HB);
    f32x4 g[8];
#pragma unroll
    for (int i = 0; i < 4; ++i) { g[2 * i] = *(const f32x4*)(gf + i * 512 + lane * 8); g[2 * i + 1] = *(const f32x4*)(gf + i * 512 + lane * 8 + 4); }
    for (int row = gw; row < M_; row += NGW) {
        float t = ssqp[(size_t)row * 32 + (lane & 31)];
        u32x4 v[4];
#pragma unroll
        for (int i = 0; i < 4; ++i) v[i] = *(const u32x4*)(HBp + (size_t)row * 2048 + i * 512 + lane * 8);
#pragma unroll
        for (int o = 1; o < 32; o <<= 1) t += shx(t, o, lane);
        const float r = rsqrtf(t * (1.0f / 2048.0f) + RMS_EPS);
#pragma unroll
        for (int i = 0; i < 4; ++i) { float* o = a.out + (size_t)row * 2048 + i * 512 + lane * 8; const f32x4 g0 = g[2 * i], g1 = g[2 * i + 1];
            *(f32x4*)o = (f32x4){bf_lo(v[i].x) * r * g0[0], bf_hi(v[i].x) * r * g0[1], bf_lo(v[i].y) * r * g0[2], bf_hi(v[i].y) * r * g0[3]};
            *(f32x4*)(o + 4) = (f32x4){bf_lo(v[i].z) * r * g1[0], bf_hi(v[i].z) * r * g1[1], bf_lo(v[i].w) * r * g1[2], bf_hi(v[i].w) * r * g1[3]}; }
    }
}

#define GRID_BAR() do { XcdBarrier xb_ = xbar; asm volatile("" : "+s"(xb_.bar), "+s"(xb_.x)); xcd_barrier(xb_); } while (0)
#ifndef REP_NULL
#define REP_NULL 0
#endif
#ifndef REP_SCAN
#define REP_SCAN 1
#endif
#ifndef REP_GATES
#define REP_GATES 1
#endif
#ifndef REP_CONV
#define REP_CONV 1
#endif
#ifndef REP_MLL
#define REP_MLL 1
#endif
#ifndef REP_MLO
#define REP_MLO 1
#endif
#ifndef REP_PRO
#define REP_PRO 1
#endif
#ifndef REP_G1
#define REP_G1 1
#endif
#ifndef REP_ML
#define REP_ML 1
#endif
#ifndef REP_FFN
#define REP_FFN 1
#endif
#ifndef REP_RG
#define REP_RG 1
#endif
#ifndef REP_G5
#define REP_G5 1
#endif
#ifndef EXTRA_SYNC
#define EXTRA_SYNC 0
#endif
__global__ void __launch_bounds__(NTHR, 2) fwd_megakernel(Args a_by_value) {
    extern __shared__ __attribute__((aligned(16))) unsigned char lds_raw[];
    LAS unsigned char* lds = (LAS unsigned char*)lds_raw;
    cg::grid_group grid = cg::this_grid();
    if (threadIdx.x == 0) { ((volatile LAS unsigned*)(lds + LDS_MISC))[0] = 0u; ((volatile LAS unsigned*)(lds + LDS_MISC))[1] = 0u; }
    __syncthreads();
    const XcdBarrier xbar = xcd_barrier_post((unsigned*)(a_by_value.ws + WS_BAR), (volatile LAS unsigned*)(lds + LDS_MISC));
    const int wave0 = __builtin_amdgcn_readfirstlane(threadIdx.x >> 6);
#define KARGS() const __attribute__((address_space(4))) Args* kap_ = (const __attribute__((address_space(4))) Args*)__builtin_amdgcn_kernarg_segment_ptr(); asm volatile("" : "+s"(kap_)); KA a = *kap_
#define IDS() KARGS(); const int lane = launder_v(__builtin_amdgcn_mbcnt_hi(~0u, __builtin_amdgcn_mbcnt_lo(~0u, 0u))), wave = launder_s(wave0), tid = wave * 64 + lane, bid = launder_s(blockIdx.x), gtid = bid * NTHR + tid; (void)lane; (void)wave; (void)gtid
    const int G = gridDim.x, nthr = G * NTHR;
#define ssq ((float*)(a.ws + WS_SSQ))
#define HB ((bf16_t*)(a.ws + WS_HB))

    for (int rep = 0; rep < REP_PRO; ++rep) { { IDS(); prologue(a, lds, bid, G, lane, wave); }
    GRID_BAR(); }
    if (gridDim.x > 65536u) grid.sync();
    for (int rep = 0; rep < EXTRA_SYNC; ++rep) GRID_BAR();
#define GEMM_RES(AOFF, WOFF, KK, SSQI) { KARGS(); pg8::Gemm g{(const bf16_t*)(a.ws + (AOFF)), (const bf16_t*)(a.ws + (WOFF)), M_, 2048, (KK), (KK), (KK), wave0}; pg8::StaticOrder S; S.init(M_, 2048, G, (int)blockIdx.x); \
        pg8::EpiResidual E{HB, ssq + (size_t)(SSQI) * SSQ_STAGE}; pg8::gemm_phase<pg8::EpiResidual, pg8::StaticOrder, true, true>(lds, g, S, E); } GRID_BAR()
#define GEMM_FFN_IN(WOFF, SSQI) { KARGS(); pg8::Gemm g{HB, (const bf16_t*)(a.ws + (WOFF)), M_, 2 * DFF_, 2048, 2048, 2048, wave0}; pg8::StaticOrder S; S.init(M_, 2 * DFF_, G, (int)blockIdx.x); \
        pg8::EpiSwiglu E{(bf16_t*)(a.ws + WS_R0), ssq + (size_t)(SSQI) * SSQ_STAGE}; pg8::gemm_phase<pg8::EpiSwiglu, pg8::StaticOrder, true, true>(lds, g, S, E); } GRID_BAR()
    for (int rep = 0; rep < REP_G1; ++rep) { if (rep) GRID_BAR(); KARGS(); pg8::Gemm g{HB, (const bf16_t*)(a.ws + WS_WM_IN), M_, 6144, 2048, 2048, 2048, wave0}; pg8::StaticOrder S; S.init(M_, 6144, G, (int)blockIdx.x);
      pg8::EpiMlstmIn E{(bf16_t*)(a.ws + WS_R0), (bf16_t*)(a.ws + WS_R0 + 32 * MiB), (bf16_t*)(a.ws + WS_R1), (bf16_t*)(a.ws + WS_R2), ssq};
      pg8::gemm_phase<pg8::EpiMlstmIn, pg8::StaticOrder, true, true>(lds, g, S, E); }
    GRID_BAR();
    for (int rep = 0; rep < REP_ML * REP_MLL; ++rep) { { IDS(); mlstm_local(a, lds, tid, lane, wave); }
    GRID_BAR(); }
    { IDS(); mlstm_scan(a, gtid, nthr); }
    GRID_BAR();
    for (int rep = 0; rep < REP_ML * REP_MLO; ++rep) { { IDS(); mlstm_out(a, lds, tid, lane, wave); }
    GRID_BAR(); }
    GEMM_RES(WS_R3, WS_WM_OUT, 2048, 1);
    for (int rep = 0; rep < REP_FFN; ++rep) { GEMM_FFN_IN(WS_WF_IN0, 1); }
    for (int rep = 0; rep < REP_NULL; ++rep) { { KARGS(); pg8::Gemm g{HB, (const bf16_t*)(a.ws + WS_WF_IN0), M_, 2 * DFF_, 2048, 2048, 2048, wave0}; pg8::StaticOrder S; S.init(M_, 2 * DFF_, G, (int)blockIdx.x);
        pg8::EpiNull E{(float*)(a.ws + WS_SP)}; pg8::gemm_phase<pg8::EpiNull, pg8::StaticOrder, true, true>(lds, g, S, E); } GRID_BAR(); }
    GEMM_RES(WS_R0, WS_WF_OUT0, DFF_, 2);
    for (int rep = 0; rep < REP_G5; ++rep) { if (rep) GRID_BAR(); KARGS(); pg8::Gemm g{HB, (const bf16_t*)(a.ws + WS_WR_IN), M_, 4096, 2048, 2048, 2048, wave0}; pg8::StaticOrder S; S.init(M_, 4096, G, (int)blockIdx.x);
      pg8::EpiRgIn E{(bf16_t*)(a.ws + WS_R0), (bf16_t*)(a.ws + WS_R1), ssq + 2 * SSQ_STAGE};
      pg8::gemm_phase<pg8::EpiRgIn, pg8::StaticOrder, true, true>(lds, g, S, E); }
    GRID_BAR();
    for (int rep = 0; rep < REP_RG * REP_CONV; ++rep) { { IDS(); rg_conv(a, gtid, nthr); }
    GRID_BAR(); }
    for (int rep = 0; rep < REP_RG * REP_GATES; ++rep) { if (rep) GRID_BAR(); KARGS(); pg8::Gemm g{(const bf16_t*)(a.ws + WS_R2), (const bf16_t*)(a.ws + WS_WG), M_, 4096, 256, 2048, 256, wave0}; pg8::GateOrder S; S.init(M_, 4096, G, (int)blockIdx.x);
      pg8::EpiRgGates E{(const bf16_t*)(a.ws + WS_R2), (bf16_t*)(a.ws + WS_R3), (bf16_t*)(a.ws + WS_R1), a.in[I_RGB], a.in[I_RAP]};
      pg8::gemm_phase<pg8::EpiRgGates, pg8::GateOrder, true, true>(lds, g, S, E); }
    GRID_BAR();
    for (int rep = 0; rep < REP_RG * REP_SCAN; ++rep) { { IDS(); rg_scan1(a, gtid, nthr); }
    GRID_BAR(); }
    for (int rep = 0; rep < REP_RG * REP_SCAN; ++rep) { { IDS(); rg_scan2(a, gtid, nthr); }
    GRID_BAR(); }
    GEMM_RES(WS_R2, WS_WR_OUT, 2048, 3);
    for (int rep = 0; rep < REP_FFN; ++rep) { GEMM_FFN_IN(WS_WF_IN1, 3); }
    GEMM_RES(WS_R0, WS_WF_OUT1, DFF_, 4);
    { IDS(); final_norm(a, bid * 8 + wave, G * 8, lane); }
}

extern "C" void kernel_launch(void* const* d_in, const int* in_sizes, int n_in, void* d_out, int out_size, void* d_ws, size_t ws_size, hipStream_t stream) {
    static int grid = 0;
    if (grid == 0) {
        if (n_in != 17 || out_size != M_ * D_ || ws_size < WS_END) { fprintf(stderr, "kernel_launch: unexpected problem (n_in %d, out %d, ws %zu)\n", n_in, out_size, ws_size); grid = -1; return; }
        int dev = 0, cus = 0, per_cu = 0;
        hipGetDevice(&dev); hipDeviceGetAttribute(&cus, hipDeviceAttributeMultiprocessorCount, dev);
        hipFuncSetAttribute((const void*)fwd_megakernel, hipFuncAttributeMaxDynamicSharedMemorySize, LDS_BYTES);
        hipOccupancyMaxActiveBlocksPerMultiprocessor(&per_cu, (const void*)fwd_megakernel, NTHR, LDS_BYTES);
        if (per_cu < 1) { fprintf(stderr, "kernel_launch: occupancy query says %d blocks per CU\n", per_cu); per_cu = 1; }
        (void)hipGetLastError();
        grid = cus * 1;
    }
    if (grid < 0) return;
    Args a{};
    for (int i = 0; i < 17; ++i) a.in[i] = (const float*)d_in[i];
    a.out = (float*)d_out; a.ws = (unsigned char*)d_ws;
    (void)hipMemsetAsync((char*)d_ws + WS_BAR, 0, BAR_BYTES, stream);
    void* args[] = {&a};
    hipError_t e = hipLaunchCooperativeKernel((const void*)fwd_megakernel, dim3(grid), dim3(NTHR), args, LDS_BYTES, stream);
    if (e != hipSuccess) fprintf(stderr, "cooperative launch failed: %s (grid %d)\n", hipGetErrorString(e), grid);
}
```

```cpp
#include <hip/hip_runtime.h>
#include <hip/hip_cooperative_groups.h>
#include <cstdio>
namespace cg = cooperative_groups;

namespace pg8 {
#define PG8_LAS __attribute__((address_space(3)))
typedef unsigned short bf16_t;
typedef short bf16x8 __attribute__((ext_vector_type(8)));
typedef float f32x4 __attribute__((ext_vector_type(4)));
typedef unsigned u32x4 __attribute__((ext_vector_type(4)));
constexpr int BM = 256, BK = 64, HALF = 128, HTB = HALF * BK * 2  , STAGE_BYTES = 8 * HTB, NXCD = 8, WGM = 8;

__host__ __device__ __forceinline__ int lds_byte(int r, int c) { const int st = (r >> 4) * 2 + (c >> 5), rr = r & 15, cc = c & 31, ob = rr * 64 + cc * 2; return st * 1024 + (ob ^ (((ob >> 9) & 1) << 5)); }
__host__ __device__ __forceinline__ void stage_rc(int b, int& R, int& C) { const int st = b / 1024, sb = b % 1024, swz = sb ^ (((sb >> 9) & 1) << 5); R = (st >> 1) * 16 + swz / 64; C = (st & 1) * 32 + (swz % 64) / 2; }
__host__ __device__ __forceinline__ int perm32(int rho) { const int n = rho >> 4, i = rho & 15; return 8 * (i >> 2) + 4 * n + (i & 3); }
struct Unit { int pm, pn, aoff; };
struct Gemm { const bf16_t* A; const bf16_t* Bt; int M, N, K, lda, ldb, wave; };
struct StaticOrder {
    int nM, nN, nwg, G, c;
    __host__ __device__ void init(int M, int N, int G_, int c_) { nM = M / BM; nN = N / BM; nwg = nM * nN; G = G_; c = c_; }
    __host__ __device__ bool next(int i, Unit& u) const {
        const long L = (long)i * G + c; if (L >= nwg) return false;
        int wgid = (int)L; { const int q = nwg / NXCD, r = nwg % NXCD, xcd = wgid % NXCD, off = wgid / NXCD; wgid = (xcd < r ? xcd * (q + 1) : r * (q + 1) + (xcd - r) * q) + off; }
        const int nig = WGM * nN, gid = wgid / nig, fm = gid * WGM, gsz = (nM - fm) < WGM ? (nM - fm) : WGM;
        u.pm = fm + ((wgid % nig) % gsz); u.pn = (wgid % nig) / gsz; u.aoff = 0; return true;
    }
    __device__ __forceinline__ void a_ready(const Unit&) const {}
    __device__ __forceinline__ void done(const Unit&) const {}
};
__device__ __forceinline__ unsigned cvt_pk_bf16(float lo, float hi) { unsigned r; asm volatile("v_cvt_pk_bf16_f32 %0, %1, %2" : "=v"(r) : "v"(lo), "v"(hi)); return r; }
typedef float f32x2 __attribute__((ext_vector_type(2)));
template <class Epi, class Sched, bool ALIGN_EPI = false, bool SP2 = false>
__device__ __forceinline__ void gemm_phase(PG8_LAS unsigned char* lds, const Gemm g, const Sched& S, const Epi& E) {
    int lane_ = __builtin_amdgcn_mbcnt_hi(~0u, __builtin_amdgcn_mbcnt_lo(~0u, 0u)); asm volatile("" : "+v"(lane_));
    const int wid = g.wave, tid = wid * 64 + lane_, lane = tid & 63, wr = wid >> 2, wc = wid & 3, fr = lane & 15, fq = lane >> 4;
    const int K = g.K, nt = K / BK;
    unsigned voffA[2], voffB[2];
#pragma unroll
    for (int i = 0; i < 2; ++i) { int R, C; stage_rc(tid * 16 + i * 8192, R, C); const int Rb = Epi::PERM ? ((R & ~31) + perm32(R & 31)) : R;
        voffA[i] = (unsigned)(R * g.lda + C) * 2u; voffB[i] = (unsigned)(Rb * g.ldb + C) * 2u; }
    constexpr unsigned kstep = (unsigned)(BK * 2);
    const unsigned hstepA = (unsigned)HALF * g.lda * 2u, hstepB = (unsigned)HALF * g.ldb * 2u;
    const unsigned tstepA = 2u * hstepA, tstepB = 2u * hstepB;
    const unsigned ldsw = (unsigned)wid * 1024u;
    const int aoff = lds_byte(wr * 64 + fr, fq * 8), boff = lds_byte(wc * 32 + fr, fq * 8);
#define PG8_SA(b, h) (((b) * 2 + (h)) * HTB)
#define PG8_SB(b, h) ((4 + (b) * 2 + (h)) * HTB)
#define PG8_STAGE(bufoff, gbase, voff) do { _Pragma("unroll") for (int _i = 0; _i < 2; ++_i) \
        __builtin_amdgcn_global_load_lds((const unsigned*)((const char*)(gbase) + (voff)[_i]), (PG8_LAS unsigned*)(lds + (bufoff) + ldsw + _i * 8192), 16, 0, 0); } while (0)
#define PG8_LDA(dst, b, h) do { _Pragma("unroll") for (int m = 0; m < 4; ++m) _Pragma("unroll") for (int k = 0; k < 2; ++k) dst[m][k] = *(const PG8_LAS bf16x8*)(lds + PG8_SA(b, h) + aoff + m * 2048 + k * 1024); } while (0)
#define PG8_LDB(dst, b, h) do { _Pragma("unroll") for (int n = 0; n < 2; ++n) _Pragma("unroll") for (int k = 0; k < 2; ++k) dst[n][k] = *(const PG8_LAS bf16x8*)(lds + PG8_SB(b, h) + boff + n * 2048 + k * 1024); } while (0)
#define PG8_MMA(ai, bj, At, Bt) do { __builtin_amdgcn_s_setprio(1); _Pragma("unroll") for (int m = 0; m < 4; ++m) _Pragma("unroll") for (int n = 0; n < 2; ++n) _Pragma("unroll") for (int k = 0; k < 2; ++k) \
        acc[ai][bj][m][n] = __builtin_amdgcn_mfma_f32_16x16x32_bf16(Bt[n][k], At[m][k], acc[ai][bj][m][n], 0, 0, 0); __builtin_amdgcn_s_setprio(0); } while (0)
#define PG8_WAIT_V(n) asm volatile("s_waitcnt vmcnt(" #n ")" ::: "memory")
#define PG8_WAIT_L(n) asm volatile("s_waitcnt lgkmcnt(" #n ")" ::: "memory")
#define PG8_BAR __builtin_amdgcn_s_barrier()
#define PG8_SCHED __builtin_amdgcn_sched_barrier(0)
    Unit cur, nxt; int ui = 0;
    if (!S.next(0, cur)) return;
    f32x4 acc[2][2][4][2];
#pragma unroll
    for (int a = 0; a < 2; ++a)
#pragma unroll
        for (int b = 0; b < 2; ++b)
#pragma unroll
            for (int m = 0; m < 4; ++m)
#pragma unroll
                for (int n = 0; n < 2; ++n) acc[a][b][m][n] = (f32x4){0.f, 0.f, 0.f, 0.f};
    bf16x8 At[4][2], B0[2][2], B1[2][2];
    const char* cA = (const char*)g.A + (size_t)cur.pm * tstepA + cur.aoff; const char* cB = (const char*)g.Bt + (size_t)cur.pn * tstepB;
    S.a_ready(cur);
    if constexpr (SP2) {
        PG8_STAGE(PG8_SB(0, 0), cB, voffB); PG8_STAGE(PG8_SB(0, 1), cB + hstepB, voffB); PG8_STAGE(PG8_SA(0, 0), cA, voffA); PG8_STAGE(PG8_SA(0, 1), cA + hstepA, voffA);
        if (wr == 1) PG8_BAR;
        PG8_WAIT_V(2); PG8_BAR;
        PG8_STAGE(PG8_SB(1, 0), cB + kstep, voffB); PG8_STAGE(PG8_SA(1, 0), cA + kstep, voffA); PG8_STAGE(PG8_SB(1, 1), cB + hstepB + kstep, voffB);
        PG8_WAIT_V(6); PG8_BAR;
    } else {
        PG8_STAGE(PG8_SB(0, 0), cB, voffB); PG8_STAGE(PG8_SA(0, 0), cA, voffA); PG8_STAGE(PG8_SB(0, 1), cB + hstepB, voffB); PG8_STAGE(PG8_SA(0, 1), cA + hstepA, voffA);
        if (wr == 1) PG8_BAR;
        PG8_WAIT_V(4); PG8_BAR;
        PG8_STAGE(PG8_SB(1, 0), cB + kstep, voffB); PG8_STAGE(PG8_SA(1, 0), cA + kstep, voffA); PG8_STAGE(PG8_SB(1, 1), cB + hstepB + kstep, voffB);
        PG8_WAIT_V(6); PG8_BAR;
    }
    for (;;) {
        const bool has_next = S.next(ui + 1, nxt);
        const char* nA = has_next ? (const char*)g.A + (size_t)nxt.pm * tstepA + nxt.aoff : cA; const char* nB = has_next ? (const char*)g.Bt + (size_t)nxt.pn * tstepB : cB;
        for (int t = 0; t < nt; t += 2) {
            const bool last = (t == nt - 2);
            const char* a1 = cA + (size_t)(t + 1) * kstep;
            const char* a2 = last ? nA : cA + (size_t)(t + 2) * kstep; const char* b2 = last ? nB : cB + (size_t)(t + 2) * kstep;
            const char* a3 = a2 + kstep; const char* b3 = b2 + kstep;
            if (last && has_next) S.a_ready(nxt);
            if constexpr (SP2) {
            PG8_LDB(B0, 0, 0); PG8_LDB(B1, 0, 1); PG8_SCHED; PG8_LDA(At, 0, 0); PG8_STAGE(PG8_SA(1, 1), a1 + hstepA, voffA);
            PG8_WAIT_V(8); PG8_WAIT_L(0); PG8_BAR; PG8_MMA(0, 0, At, B0); PG8_MMA(0, 1, At, B1); PG8_BAR; PG8_SCHED;
            PG8_LDA(At, 0, 1); PG8_STAGE(PG8_SB(0, 0), b2, voffB); PG8_STAGE(PG8_SB(0, 1), b2 + hstepB, voffB); PG8_STAGE(PG8_SA(0, 0), a2, voffA);
            PG8_WAIT_V(8); PG8_WAIT_L(0); PG8_BAR; PG8_MMA(1, 0, At, B0); PG8_MMA(1, 1, At, B1); PG8_BAR; PG8_SCHED;
            PG8_LDB(B0, 1, 0); PG8_LDB(B1, 1, 1); PG8_SCHED; PG8_LDA(At, 1, 0); PG8_STAGE(PG8_SA(0, 1), a2 + hstepA, voffA);
            PG8_WAIT_V(8); PG8_WAIT_L(0); PG8_BAR; PG8_MMA(0, 0, At, B0); PG8_MMA(0, 1, At, B1); PG8_BAR; PG8_SCHED;
            PG8_LDA(At, 1, 1); PG8_STAGE(PG8_SB(1, 0), b3, voffB); PG8_STAGE(PG8_SB(1, 1), b3 + hstepB, voffB); PG8_STAGE(PG8_SA(1, 0), a3, voffA);
            PG8_WAIT_V(8); PG8_WAIT_L(0); PG8_BAR; PG8_MMA(1, 0, At, B0); PG8_MMA(1, 1, At, B1); PG8_BAR; PG8_SCHED;
            } else {
            PG8_LDB(B0, 0, 0); PG8_SCHED; PG8_LDA(At, 0, 0); PG8_STAGE(PG8_SA(1, 1), a1 + hstepA, voffA);
            PG8_WAIT_L(8); PG8_BAR; PG8_WAIT_L(0); PG8_MMA(0, 0, At, B0); PG8_BAR; PG8_SCHED;
            PG8_LDB(B1, 0, 1); PG8_STAGE(PG8_SB(0, 0), b2, voffB);
            PG8_BAR; PG8_WAIT_L(0); PG8_MMA(0, 1, At, B1); PG8_BAR;
            PG8_LDA(At, 0, 1); PG8_STAGE(PG8_SA(0, 0), a2, voffA);
            PG8_BAR; PG8_WAIT_L(0); PG8_MMA(1, 0, At, B0); PG8_BAR; PG8_SCHED;
            PG8_STAGE(PG8_SB(0, 1), b2 + hstepB, voffB);
            PG8_WAIT_V(6); PG8_BAR; PG8_MMA(1, 1, At, B1); PG8_BAR;
            PG8_LDB(B0, 1, 0); PG8_SCHED; PG8_LDA(At, 1, 0); PG8_STAGE(PG8_SA(0, 1), a2 + hstepA, voffA);
            PG8_WAIT_L(8); PG8_BAR; PG8_WAIT_L(0); PG8_MMA(0, 0, At, B0); PG8_BAR; PG8_SCHED;
            PG8_LDB(B1, 1, 1); PG8_STAGE(PG8_SB(1, 0), b3, voffB);
            PG8_BAR; PG8_WAIT_L(0); PG8_MMA(0, 1, At, B1); PG8_BAR;
            PG8_LDA(At, 1, 1); PG8_STAGE(PG8_SA(1, 0), a3, voffA);
            PG8_BAR; PG8_WAIT_L(0); PG8_MMA(1, 0, At, B0); PG8_BAR; PG8_SCHED;
            PG8_STAGE(PG8_SB(1, 1), b3 + hstepB, voffB);
            PG8_WAIT_V(6); PG8_BAR; PG8_MMA(1, 1, At, B1); PG8_BAR;
            }
        }
        if constexpr (ALIGN_EPI) { if (wr == 0) PG8_BAR; }
        if constexpr (!Epi::AFTER_DRAIN) { int ln_ = __builtin_amdgcn_mbcnt_hi(~0u, __builtin_amdgcn_mbcnt_lo(~0u, 0u)); asm volatile("" : "+v"(ln_)); E(acc, cur, wr, wc, ln_ & 15, ln_ >> 4); S.done(cur); }
        if (!has_next) break;
#pragma unroll
        for (int a = 0; a < 2; ++a)
#pragma unroll
            for (int b = 0; b < 2; ++b)
#pragma unroll
                for (int m = 0; m < 4; ++m)
#pragma unroll
                    for (int n = 0; n < 2; ++n) acc[a][b][m][n] = (f32x4){0.f, 0.f, 0.f, 0.f};
        cur = nxt; cA = nA; cB = nB; ++ui;
        if constexpr (ALIGN_EPI) { if (wr == 1) PG8_BAR; }
    }
    PG8_WAIT_V(0);
    if constexpr (!ALIGN_EPI) { if (wr == 0) PG8_BAR; }
    PG8_BAR;
    if constexpr (Epi::AFTER_DRAIN) { E.fused(acc, cur, wr, wc, fr, fq, lds, wid, lane); S.done(cur); }
#undef PG8_SA
#undef PG8_SB
#undef PG8_STAGE
#undef PG8_LDA
#undef PG8_LDB
#undef PG8_MMA
#undef PG8_WAIT_V
#undef PG8_WAIT_L
#undef PG8_BAR
#undef PG8_SCHED
}

typedef unsigned u32x2 __attribute__((ext_vector_type(2)));
constexpr float RMS_EPS = 1e-6f;
__device__ __forceinline__ float shx(float v, int mask, int lane) { return __int_as_float(__builtin_amdgcn_ds_bpermute((lane ^ mask) << 2, __float_as_int(v))); }
__device__ __forceinline__ float shi(float v, int src) { return __int_as_float(__builtin_amdgcn_ds_bpermute(src << 2, __float_as_int(v))); }
__device__ __forceinline__ float sigmoidf_(float x) { return __builtin_amdgcn_rcpf(1.0f + __expf(-x)); }
__device__ __forceinline__ float logsigmoidf_(float x) { const float e = __expf(-fabsf(x)), u = 1.0f + e, d = u - 1.0f; const float l = (d == 0.f) ? e : __logf(u) * (e * __builtin_amdgcn_rcpf(d)); return fminf(x, 0.f) - l; }
__device__ __forceinline__ float one_minus_exp(float y) { const float a = 1.0f - __expf(y), b = -y * (1.0f + y * (0.5f + y * (1.0f / 6.0f))); return (y > -0.01f) ? b : a; }
__device__ __forceinline__ float gelu_tanh(float x) { const float p = __builtin_fmaf(x * x, -0.10294325f, -2.3022082f); return x * __builtin_amdgcn_rcpf(1.0f + __builtin_amdgcn_exp2f(x * p)); }
__device__ __forceinline__ float bf_lo(unsigned w) { return __uint_as_float(w << 16); }
__device__ __forceinline__ float bf_hi(unsigned w) { return __uint_as_float(w & 0xffff0000u); }

__device__ __forceinline__ float row_rstd(const float* ssqp, int row, int fr, int fq) {
    const f32x4 p0 = *(const f32x4*)(ssqp + (size_t)row * 32 + fq * 8), p1 = *(const f32x4*)(ssqp + (size_t)row * 32 + fq * 8 + 4);
    float t = ((p0[0] + p0[1]) + (p0[2] + p0[3])) + ((p1[0] + p1[1]) + (p1[2] + p1[3])); const int ln = fr + 16 * fq;
    t += shx(t, 16, ln); t += shx(t, 32, ln);
    return rsqrtf(t * (1.0f / 2048.0f) + RMS_EPS);
}
struct EpiMlstmIn {
    static constexpr bool PERM = true, AFTER_DRAIN = false;
    bf16_t *Q, *Kb, *V, *O; const float* ssq;
    __device__ __forceinline__ void operator()(const f32x4 (&acc)[2][2][4][2], const Unit& u, int wr, int wc, int fr, int fq) const {
        const int row0 = u.pm * BM + wr * 64 + fr; const int pn = u.pn;
        bf16_t* base; int ldc, colt; bool sig = false;
        if (pn < 4) { base = Q; ldc = 1024; colt = pn * BM; } else if (pn < 8) { base = Kb; ldc = 1024; colt = (pn - 4) * BM; }
        else if (pn < 16) { base = V; ldc = 2048; colt = (pn - 8) * BM; } else { base = O; ldc = 2048; colt = (pn - 16) * BM; sig = true; }
        const int col0 = colt + wc * 32 + 8 * fq;
#pragma unroll
        for (int ai = 0; ai < 2; ++ai)
#pragma unroll
            for (int m = 0; m < 4; ++m) { const int row = row0 + ai * HALF + m * 16; const float rs = row_rstd(ssq, row, fr, fq);
                bf16_t* rowp = base + (size_t)row * ldc + col0;
#pragma unroll
                for (int bj = 0; bj < 2; ++bj) { f32x4 v0, v1;
                    if (sig) { const float nr = -1.4426950408889634f * rs;
#pragma unroll
                        for (int j = 0; j < 4; ++j) { v0[j] = __builtin_amdgcn_rcpf(1.0f + __builtin_amdgcn_exp2f(acc[ai][bj][m][0][j] * nr)); v1[j] = __builtin_amdgcn_rcpf(1.0f + __builtin_amdgcn_exp2f(acc[ai][bj][m][1][j] * nr)); } }
                    else { v0 = acc[ai][bj][m][0] * rs; v1 = acc[ai][bj][m][1] * rs; }
                    u32x4 w; w.x = cvt_pk_bf16(v0[0], v0[1]); w.y = cvt_pk_bf16(v0[2], v0[3]); w.z = cvt_pk_bf16(v1[0], v1[1]); w.w = cvt_pk_bf16(v1[2], v1[3]);
                    *(u32x4*)(rowp + bj * HALF) = w; }
                asm volatile("" ::: "memory"); }
    }
};
struct EpiResidual {
    static constexpr bool PERM = true, AFTER_DRAIN = false;
    bf16_t* HB; float* ssq_out;
    __device__ __forceinline__ void operator()(const f32x4 (&acc)[2][2][4][2], const Unit& u, int wr, int wc, int fr, int fq) const {
        const int row0 = u.pm * BM + wr * 64 + fr, col0 = u.pn * BM + wc * 32 + 8 * fq;
#pragma unroll
        for (int ai = 0; ai < 2; ++ai)
#pragma unroll
            for (int m = 0; m < 4; ++m) { const int row = row0 + ai * HALF + m * 16; bf16_t* bp = HB + (size_t)row * 2048 + col0; float s = 0.f;
                u32x4 hv[2];
#pragma unroll
                for (int bj = 0; bj < 2; ++bj) hv[bj] = *(const u32x4*)(bp + bj * HALF);
#pragma unroll
                for (int bj = 0; bj < 2; ++bj) { const f32x4 a0 = acc[ai][bj][m][0], a1 = acc[ai][bj][m][1]; const u32x4 x = hv[bj];
                    const float h0 = bf_lo(x.x) + a0[0], h1 = bf_hi(x.x) + a0[1], h2 = bf_lo(x.y) + a0[2], h3 = bf_hi(x.y) + a0[3], h4 = bf_lo(x.z) + a1[0], h5 = bf_hi(x.z) + a1[1], h6 = bf_lo(x.w) + a1[2], h7 = bf_hi(x.w) + a1[3];
                    s += (h0 * h0 + h1 * h1) + (h2 * h2 + h3 * h3) + (h4 * h4 + h5 * h5) + (h6 * h6 + h7 * h7);
                    u32x4 w; w.x = cvt_pk_bf16(h0, h1); w.y = cvt_pk_bf16(h2, h3); w.z = cvt_pk_bf16(h4, h5); w.w = cvt_pk_bf16(h6, h7); *(u32x4*)(bp + bj * HALF) = w; }
                { const int ln = fr + 16 * fq; s += shx(s, 16, ln); s += shx(s, 32, ln); }
                if (fq == 0) ssq_out[(size_t)row * 32 + u.pn * 4 + wc] = s;
                asm volatile("" ::: "memory"); }
    }
};
struct EpiSwiglu {
    static constexpr bool PERM = true, AFTER_DRAIN = false;
    bf16_t* ACT; const float* ssq;
    __device__ __forceinline__ void operator()(const f32x4 (&acc)[2][2][4][2], const Unit& u, int wr, int wc, int fr, int fq) const {
        const int row0 = u.pm * BM + wr * 64 + fr, ch0 = u.pn * 128 + wc * 32 + 8 * fq;
#pragma unroll
        for (int ai = 0; ai < 2; ++ai)
#pragma unroll
            for (int m = 0; m < 4; ++m) { const int row = row0 + ai * HALF + m * 16; const float rs = row_rstd(ssq, row, fr, fq), rs2 = rs * rs, nrl = -1.4426950408889634f * rs;
                float o[8];
#pragma unroll
                for (int n = 0; n < 2; ++n) { const f32x4 g = acc[ai][0][m][n], gu = g * acc[ai][1][m][n] * rs2;
#pragma unroll
                    for (int j = 0; j < 4; ++j) o[4 * n + j] = gu[j] * __builtin_amdgcn_rcpf(1.0f + __builtin_amdgcn_exp2f(g[j] * nrl)); }
                u32x4 w; w.x = cvt_pk_bf16(o[0], o[1]); w.y = cvt_pk_bf16(o[2], o[3]); w.z = cvt_pk_bf16(o[4], o[5]); w.w = cvt_pk_bf16(o[6], o[7]);
                *(u32x4*)(ACT + (size_t)row * 5632 + ch0) = w;
                asm volatile("" ::: "memory"); }
    }
};
struct EpiRgIn {
    static constexpr bool PERM = true, AFTER_DRAIN = false;
    bf16_t *GG, *REC; const float* ssq;
    __device__ __forceinline__ void operator()(const f32x4 (&acc)[2][2][4][2], const Unit& u, int wr, int wc, int fr, int fq) const {
        const int row0 = u.pm * BM + wr * 64 + fr; const bool gate = u.pn < 8;
        bf16_t* base = gate ? GG : REC; const int col0 = (gate ? u.pn : u.pn - 8) * BM + wc * 32 + 8 * fq;
#pragma unroll
        for (int ai = 0; ai < 2; ++ai)
#pragma unroll
            for (int m = 0; m < 4; ++m) { const int row = row0 + ai * HALF + m * 16; const float rs = row_rstd(ssq, row, fr, fq);
                bf16_t* rowp = base + (size_t)row * 2048 + col0;
#pragma unroll
                for (int bj = 0; bj < 2; ++bj) { f32x4 v0 = acc[ai][bj][m][0] * rs, v1 = acc[ai][bj][m][1] * rs;
                    if (gate) {
#pragma unroll
                        for (int j = 0; j < 4; ++j) { v0[j] = gelu_tanh(v0[j]); v1[j] = gelu_tanh(v1[j]); } }
                    u32x4 w; w.x = cvt_pk_bf16(v0[0], v0[1]); w.y = cvt_pk_bf16(v0[2], v0[3]); w.z = cvt_pk_bf16(v1[0], v1[1]); w.w = cvt_pk_bf16(v1[2], v1[3]);
                    *(u32x4*)(rowp + bj * HALF) = w; }
                asm volatile("" ::: "memory"); }
    }
};
struct EpiRgGates {
    static constexpr bool PERM = true, AFTER_DRAIN = false;
    const bf16_t* XC; bf16_t *LA, *U; const float *gate_b, *a_param;
    __device__ __forceinline__ void operator()(const f32x4 (&acc)[2][2][4][2], const Unit& u, int wr, int wc, int fr, int fq) const {
        const int row0 = u.pm * BM + wr * 64 + fr, blk = u.pn >> 1, lh = u.pn & 1;
        const int chb = 128 * lh + 32 * wc + 8 * fq, chg = blk * 256 + chb;
        f32x4 br[2], bi[2], ls[2];
        constexpr float NL2E = -1.4426950408889634f;
#pragma unroll
        for (int n = 0; n < 2; ++n) { br[n] = *(const f32x4*)(gate_b + blk * 512 + chb + 4 * n) * NL2E; bi[n] = *(const f32x4*)(gate_b + blk * 512 + 256 + chb + 4 * n) * NL2E;
            const f32x4 ap = *(const f32x4*)(a_param + chg + 4 * n);
#pragma unroll
            for (int j = 0; j < 4; ++j) ls[n][j] = 8.0f * logsigmoidf_(ap[j]); }
#pragma unroll
        for (int ai = 0; ai < 2; ++ai)
#pragma unroll
            for (int m = 0; m < 4; ++m) { const size_t rowoff = (size_t)(row0 + ai * HALF + m * 16) * 2048 + chg;
                const u32x4 xw = *(const u32x4*)(XC + rowoff);
                const float xc[8] = {bf_lo(xw.x), bf_hi(xw.x), bf_lo(xw.y), bf_hi(xw.y), bf_lo(xw.z), bf_hi(xw.z), bf_lo(xw.w), bf_hi(xw.w)}; float la[8], uu[8];
#pragma unroll
                for (int n = 0; n < 2; ++n)
#pragma unroll
                    for (int j = 0; j < 4; ++j) { const float r = __builtin_amdgcn_rcpf(1.0f + __builtin_amdgcn_exp2f(__builtin_fmaf(acc[ai][0][m][n][j], NL2E, br[n][j])));
                        const float ig = __builtin_amdgcn_rcpf(1.0f + __builtin_amdgcn_exp2f(__builtin_fmaf(acc[ai][1][m][n][j], NL2E, bi[n][j])));
                        const float l = r * ls[n][j]; la[4 * n + j] = l;
                        uu[4 * n + j] = __builtin_amdgcn_sqrtf(1.0f - __builtin_amdgcn_exp2f(l * 2.8853900817779268f)) * ig * xc[4 * n + j]; }
                u32x4 w; w.x = cvt_pk_bf16(la[0], la[1]); w.y = cvt_pk_bf16(la[2], la[3]); w.z = cvt_pk_bf16(la[4], la[5]); w.w = cvt_pk_bf16(la[6], la[7]); *(u32x4*)(LA + rowoff) = w;
                w.x = cvt_pk_bf16(uu[0], uu[1]); w.y = cvt_pk_bf16(uu[2], uu[3]); w.z = cvt_pk_bf16(uu[4], uu[5]); w.w = cvt_pk_bf16(uu[6], uu[7]); *(u32x4*)(U + rowoff) = w;
                asm volatile("" ::: "memory"); }
    }
};
struct EpiNull { static constexpr bool PERM = true, AFTER_DRAIN = false; float* sink;
    __device__ __forceinline__ void operator()(const f32x4 (&acc)[2][2][4][2], const Unit& u, int wr, int wc, int fr, int fq) const {
        float s = 0.f;
#pragma unroll
        for (int ai = 0; ai < 2; ++ai)
#pragma unroll
            for (int bj = 0; bj < 2; ++bj)
#pragma unroll
                for (int m = 0; m < 4; ++m)
#pragma unroll
                    for (int n = 0; n < 2; ++n) s += acc[ai][bj][m][n][0] + acc[ai][bj][m][n][1] + acc[ai][bj][m][n][2] + acc[ai][bj][m][n][3];
        if (s == 1.2345e-30f) sink[0] = s; } };
struct GateOrder : StaticOrder {
    __device__ bool next(int i, Unit& u) const { if (!StaticOrder::next(i, u)) return false; u.aoff = (u.pn >> 1) * 512; return true; }
};
}

#define LAS __attribute__((address_space(3)))
using pg8::bf16_t; using pg8::bf16x8; using pg8::f32x4; using pg8::u32x4; using pg8::u32x2; using pg8::cvt_pk_bf16; using pg8::bf_lo; using pg8::bf_hi; using pg8::RMS_EPS; using pg8::shx; using pg8::shi; using pg8::logsigmoidf_;
typedef short s16x4 __attribute__((ext_vector_type(4)));
typedef float f32x2_ __attribute__((ext_vector_type(2)));
constexpr int M_ = 16384, D_ = 2048, S_ = 8192, DFF_ = 5632, NTHR = 512;
constexpr size_t MiB = 1u << 20;
constexpr size_t WS_SSQ = 552 * MiB, SSQ_STAGE = (size_t)16384 * 32;
constexpr size_t WS_IG = 1 * MiB, WS_LF = 1 * MiB + 512 * 1024;
constexpr size_t WS_NL = 2 * MiB;
constexpr size_t WS_ML = 2 * MiB + 256 * 1024, WS_BT = WS_ML + 4096, WS_MS = WS_BT + 4096;
constexpr size_t WS_SP = 3 * MiB, WS_SH = 4 * MiB; constexpr size_t WS_BAR = 5 * MiB, BAR_BYTES = 16384;
constexpr int LDS_MISC = 131072;
constexpr size_t WS_WM_IN = 8 * MiB, WS_WM_OUT = 32 * MiB, WS_WF_IN0 = 40 * MiB, WS_WF_IN1 = 84 * MiB, WS_WF_OUT0 = 128 * MiB, WS_WF_OUT1 = 150 * MiB,
                 WS_WR_IN = 172 * MiB, WS_WG = 188 * MiB, WS_WR_OUT = 190 * MiB;
constexpr size_t WS_HB = 200 * MiB;
constexpr size_t WS_R0 = 264 * MiB, WS_R1 = 328 * MiB, WS_R2 = 392 * MiB, WS_R3 = 456 * MiB;
constexpr size_t WS_CL = 520 * MiB, WS_END = 562 * MiB;
constexpr int LDS_BYTES = 147456;

struct Args { const float* in[17]; float* out; unsigned char* ws; };
typedef const __attribute__((address_space(4))) Args& KA;
enum { I_X = 0, I_NMIX, I_NFFN, I_NFIN, I_MWIN, I_MBIF, I_MHN, I_MWOUT, I_RWIN, I_RCW, I_RCB, I_RGW, I_RGB, I_RAP, I_RWOUT, I_FWIN, I_FWOUT };

__device__ __forceinline__ int launder_v(int v) { asm volatile("" : "+v"(v)); return v; }
__device__ __forceinline__ int launder_s(int v) { asm volatile("" : "+s"(v)); return v; }
__device__ __forceinline__ void lds_wait() { asm volatile("s_waitcnt lgkmcnt(0)" ::: "memory"); }
__device__ __forceinline__ float bf2f(unsigned short v) { return __uint_as_float((unsigned)v << 16); }

#define XB_TMO      128
#define XB_XCNT(j)  (256  + 64 * (j))
#define XB_XSUB(j)  (1280 + 64 * (j))
#define XB_XGEN(j)  (2304 + 64 * (j))
#define XB_TOP      3328
#define XB_TOPGEN   3392
#define XCD_BAR_WORDS 3456
#define XB_SPIN_CAP (1u << 18)

__device__ __forceinline__ unsigned xb_ld(unsigned* p)              { return __hip_atomic_load(p, __ATOMIC_RELAXED, __HIP_MEMORY_SCOPE_AGENT); }
__device__ __forceinline__ unsigned xb_add(unsigned* p, unsigned v) { return __hip_atomic_fetch_add(p, v, __ATOMIC_RELAXED, __HIP_MEMORY_SCOPE_AGENT); }
__device__ __forceinline__ unsigned xb_xcc_id() { return (unsigned)__builtin_amdgcn_s_getreg((3 << 11) | 20) & 0xFu; }
#define XB_SPIN(cond, bar) do { unsigned _sp = 0; while (cond) { __builtin_amdgcn_s_sleep(1); \
    if ((++_sp & 255u) == 0u) { if (xb_ld(&(bar)[XB_TMO])) break; if (_sp > XB_SPIN_CAP) { atomicAdd(&(bar)[XB_TMO], 1u); break; } } } } while (0)

struct XcdBarrier {
    unsigned* bar; unsigned x;
    volatile LAS unsigned* st;
};

__device__ __forceinline__ XcdBarrier xcd_barrier_post(unsigned* bar, volatile LAS unsigned* st) {
    XcdBarrier b; b.bar = bar; b.x = xb_xcc_id(); b.st = st;
    if (threadIdx.x == 0) (void)xb_add(&bar[XB_XCNT(b.x)], 1u);
    return b;
}
__device__ __forceinline__ void xcd_barrier_complete(unsigned* bar, unsigned x, unsigned& nloc, unsigned& nx) {
    const unsigned G = gridDim.x * gridDim.y * gridDim.z;
    unsigned sum, cnt, mine, sp = 0u;
    for (;;) {
        sum = 0u; cnt = 0u; mine = 0u;
#pragma unroll
        for (unsigned j = 0; j < 16; ++j) { const unsigned c = xb_ld(&bar[XB_XCNT(j)]); sum += c; cnt += (c > 0u) ? 1u : 0u; mine = (j == x) ? c : mine; }
        if (sum == G) break;
        __builtin_amdgcn_s_sleep(1);
        if ((++sp & 255u) == 0u) { if (xb_ld(&bar[XB_TMO])) break; if (sp > XB_SPIN_CAP) { atomicAdd(&bar[XB_TMO], 1u); break; } }
    }
    nloc = mine > 0u ? mine : 1u; nx = cnt > 0u ? cnt : 1u;
}

__device__ __forceinline__ void xcd_barrier(const XcdBarrier& b) {
    asm volatile("s_waitcnt vmcnt(0)" ::: "memory");
    __syncthreads();
    if (threadIdx.x == 0) {
        unsigned* bar = b.bar;
        __builtin_amdgcn_s_waitcnt(0);
        unsigned nloc = b.st[0], nx = b.st[1];
        if (nloc == 0u) { xcd_barrier_complete(bar, b.x, nloc, nx); b.st[0] = nloc; b.st[1] = nx; }
        const unsigned old = xb_add(&bar[XB_XSUB(b.x)], 1u);
        const unsigned gen = old / nloc;
        if (old + 1u == (gen + 1u) * nloc) {
            __builtin_amdgcn_fence(__ATOMIC_RELEASE, "agent");
            asm volatile("s_waitcnt vmcnt(0)" ::: "memory");
            const unsigned og = xb_add(&bar[XB_TOP], 1u);
            const unsigned tg = og / nx;
            if (og + 1u == (tg + 1u) * nx) xb_add(&bar[XB_TOPGEN], 1u);
            else XB_SPIN(xb_ld(&bar[XB_TOPGEN]) == tg, bar);
            __builtin_amdgcn_fence(__ATOMIC_ACQUIRE, "agent");
            xb_add(&bar[XB_XGEN(b.x)], 1u);
            asm volatile("s_waitcnt vmcnt(0)" ::: "memory");
        } else {
            XB_SPIN(xb_ld(&bar[XB_XGEN(b.x)]) == gen, bar);
            __builtin_amdgcn_fence(__ATOMIC_ACQUIRE, "agent");
            asm volatile("s_waitcnt vmcnt(0)" ::: "memory");
        }
    }
    __syncthreads();
}

struct CvtJob { const float* W; const float* gk; bf16_t* WT; int K, ldn, N, mode, item; };
struct CvtRegs { float vv[32]; f32x4 g0, g1; };
__device__ __forceinline__ void cvt_load(const CvtJob& j, CvtRegs& R, int lane) {
    const int nblk = j.N >> 5, kb = j.item / nblk, nb = j.item - kb * nblk, k0 = kb * 64, n0 = nb * 32;
    const float* p = j.W + (size_t)(k0 + (lane >> 5)) * j.ldn + n0 + (lane & 31);
#pragma unroll
    for (int i = 0; i < 32; ++i) R.vv[i] = p[(size_t)(2 * i) * j.ldn];
    if (j.gk) { R.g0 = *(const f32x4*)(j.gk + k0 + 8 * (lane & 7)); R.g1 = *(const f32x4*)(j.gk + k0 + 8 * (lane & 7) + 4); }
    else { R.g0 = (f32x4){1.f, 1.f, 1.f, 1.f}; R.g1 = R.g0; }
}
__device__ __forceinline__ void cvt_store(const CvtJob& j, CvtRegs& R, LAS float* scr, int lane) {
    const int nblk = j.N >> 5, kb = j.item / nblk, nb = j.item - kb * nblk, k0 = kb * 64, n0 = nb * 32, mode = j.mode, K = j.K;
#pragma unroll
    for (int i = 0; i < 32; ++i) scr[(2 * i + (lane >> 5)) * 33 + (lane & 31)] = R.vv[i];
    lds_wait();
    const int c = lane & 7;
#pragma unroll
    for (int jj = 0; jj < 4; ++jj) { const int n = (lane >> 3) + 8 * jj, col = n0 + n; const LAS float* sp = scr + (8 * c) * 33 + n;
        float cs = 1.f; int dest = col;
        if (mode == 1) { cs = (col >= 1024 && col < 2048) ? 0.08838834764831845f : 1.f; }
        else if (mode == 2) { const int nn = col >= 5632 ? 1 : 0, ch = col - nn * 5632; dest = 256 * (ch >> 7) + 128 * nn + (ch & 127); }
        else if (mode == 3) { const int nn = col >= 256 ? 1 : 0, ch = col - nn * 256; dest = 256 * (ch >> 7) + 128 * nn + (ch & 127); }
        const f32x4 g0 = R.g0 * cs, g1 = R.g1 * cs;
        u32x4 o; o.x = cvt_pk_bf16(sp[0 * 33] * g0[0], sp[1 * 33] * g0[1]); o.y = cvt_pk_bf16(sp[2 * 33] * g0[2], sp[3 * 33] * g0[3]); o.z = cvt_pk_bf16(sp[4 * 33] * g1[0], sp[5 * 33] * g1[1]); o.w = cvt_pk_bf16(sp[6 * 33] * g1[2], sp[7 * 33] * g1[3]);
        *(u32x4*)(j.WT + (size_t)dest * K + k0 + 8 * c) = o; }
    lds_wait();
}
__device__ __forceinline__ void x_half(KA a, int grp, int half, int lane, f32x4& acc, float& ss) {
    const float* __restrict__ x = a.in[I_X]; const float* __restrict__ W = a.in[I_MWIN]; const float* __restrict__ gmix = a.in[I_NMIX];
    bf16_t* XB = (bf16_t*)(a.ws + WS_HB);
    const int row0 = grp * 16, r = lane & 15, quad = lane >> 4, kbase = half * 1024;
    const float* xr = x + (size_t)(row0 + r) * D_ + quad * 8 + kbase; bf16_t* br = XB + (size_t)(row0 + r) * D_ + quad * 8 + kbase;
    const float* wp = W + (size_t)(kbase + quad * 8) * 6160 + 6144 + r; const float* gp = gmix + kbase + quad * 8;
    acc = (f32x4){0.f, 0.f, 0.f, 0.f}; ss = 0.f;
#pragma unroll 4
    for (int k0 = 0; k0 < 1024; k0 += 32) {
        const f32x4 a0 = *(const f32x4*)(xr + k0), a1 = *(const f32x4*)(xr + k0 + 4);
        ss += (a0[0] * a0[0] + a0[1] * a0[1]) + (a0[2] * a0[2] + a0[3] * a0[3]) + (a1[0] * a1[0] + a1[1] * a1[1]) + (a1[2] * a1[2] + a1[3] * a1[3]);
        u32x4 aw; aw.x = cvt_pk_bf16(a0[0], a0[1]); aw.y = cvt_pk_bf16(a0[2], a0[3]); aw.z = cvt_pk_bf16(a1[0], a1[1]); aw.w = cvt_pk_bf16(a1[2], a1[3]);
        *(u32x4*)(br + k0) = aw;
        const f32x4 g0 = *(const f32x4*)(gp + k0), g1 = *(const f32x4*)(gp + k0 + 4);
        const float* w = wp + (size_t)k0 * 6160;
        u32x4 bw; bw.x = cvt_pk_bf16(w[0] * g0[0], w[6160] * g0[1]); bw.y = cvt_pk_bf16(w[2 * 6160] * g0[2], w[3 * 6160] * g0[3]);
        bw.z = cvt_pk_bf16(w[4 * 6160] * g1[0], w[5 * 6160] * g1[1]); bw.w = cvt_pk_bf16(w[6 * 6160] * g1[2], w[7 * 6160] * g1[3]);
        acc = __builtin_amdgcn_mfma_f32_16x16x32_bf16(__builtin_bit_cast(bf16x8, aw), __builtin_bit_cast(bf16x8, bw), acc, 0, 0, 0);
    }
}
__device__ __forceinline__ void x_finish(KA a, int grp, int lane, f32x4 acc, float ss) {
    float* ssq0 = (float*)(a.ws + WS_SSQ);
    const int row0 = grp * 16, r = lane & 15, quad = lane >> 4;
    ss += shx(ss, 16, lane); ss += shx(ss, 32, lane);
    { const f32x4 z = {0.f, 0.f, 0.f, 0.f}; f32x4 first = z; if (quad == 0) first[0] = ss; float* sp = ssq0 + (size_t)(row0 + r) * 32 + quad * 8; *(f32x4*)sp = first; *(f32x4*)(sp + 4) = z; }
    const int n = r; const float bias = a.in[I_MBIF][n];
    float* IG = (float*)(a.ws + WS_IG); float* LF = (float*)(a.ws + WS_LF);
#pragma unroll
    for (int rr = 0; rr < 4; ++rr) { const int row = 4 * quad + rr; const float srow = shi(ss, row); const float rs = rsqrtf(srow * (1.0f / 2048.0f) + RMS_EPS);
        const float pre = acc[rr] * rs + bias; const int grow = row0 + row, b = grow >> 13, t = grow & 8191, h = n & 7; const size_t idx = (size_t)(b * 8 + h) * S_ + t;
        if (n < 8) IG[idx] = pre; else LF[idx] = logsigmoidf_(pre); }
}
__device__ __forceinline__ bool cvt_decode(KA a, int r, CvtJob& j) {
    constexpr int I0 = 32 * 192, I1 = 32 * 64, I2 = 32 * 352, I4 = 88 * 64, I6 = 32 * 128, I7 = 8 * 64, I8 = 32 * 64;
    j.gk = nullptr; j.mode = 0; j.K = 2048; j.ldn = 2048; j.N = 2048;
    if (r < I0) { j.W = a.in[I_MWIN]; j.ldn = 6160; j.N = 6144; j.WT = (bf16_t*)(a.ws + WS_WM_IN); j.mode = 1; j.gk = a.in[I_NMIX]; j.item = r; return true; } r -= I0;
    if (r < I1) { j.W = a.in[I_MWOUT]; j.WT = (bf16_t*)(a.ws + WS_WM_OUT); j.item = r; return true; } r -= I1;
    if (r < I2) { j.W = a.in[I_FWIN]; j.ldn = 11264; j.N = 11264; j.WT = (bf16_t*)(a.ws + WS_WF_IN0); j.mode = 2; j.gk = a.in[I_NFFN]; j.item = r; return true; } r -= I2;
    if (r < I2) { j.W = a.in[I_FWIN] + (size_t)2048 * 11264; j.ldn = 11264; j.N = 11264; j.WT = (bf16_t*)(a.ws + WS_WF_IN1); j.mode = 2; j.gk = a.in[I_NFFN] + 2048; j.item = r; return true; } r -= I2;
    if (r < I4) { j.W = a.in[I_FWOUT]; j.K = 5632; j.WT = (bf16_t*)(a.ws + WS_WF_OUT0); j.item = r; return true; } r -= I4;
    if (r < I4) { j.W = a.in[I_FWOUT] + (size_t)5632 * 2048; j.K = 5632; j.WT = (bf16_t*)(a.ws + WS_WF_OUT1); j.item = r; return true; } r -= I4;
    if (r < I6) { j.W = a.in[I_RWIN]; j.ldn = 4096; j.N = 4096; j.WT = (bf16_t*)(a.ws + WS_WR_IN); j.gk = a.in[I_NMIX] + 2048; j.item = r; return true; } r -= I6;
    if (r < I7) { const int blk = r >> 6; j.W = a.in[I_RGW] + (size_t)blk * 256 * 512; j.K = 256; j.ldn = 512; j.N = 512; j.WT = (bf16_t*)(a.ws + WS_WG) + (size_t)blk * 512 * 256; j.mode = 3; j.item = r & 63; return true; } r -= I7;
    if (r < I8) { j.W = a.in[I_RWOUT]; j.WT = (bf16_t*)(a.ws + WS_WR_OUT); j.item = r; return true; }
    return false;
}
__device__ __forceinline__ void prologue(KA a, LAS unsigned char* lds, int bid, int G, int lane, int wave) {
    LAS float* scr = (LAS float*)(lds + wave * 16384);
    for (int g0 = bid * 4; g0 < M_ / 16; g0 += G * 4) {
        const int grp = g0 + (wave & 3); f32x4 acc; float ss;
        x_half(a, grp, wave >> 2, lane, acc, ss);
        LAS float* xs = (LAS float*)(lds + (wave & 3) * 16384 + 12288) + lane * 5;
        if (wave >= 4) { xs[0] = acc[0]; xs[1] = acc[1]; xs[2] = acc[2]; xs[3] = acc[3]; xs[4] = ss; }
        __syncthreads();
        if (wave < 4) { acc[0] += xs[0]; acc[1] += xs[1]; acc[2] += xs[2]; acc[3] += xs[3]; ss += xs[4]; x_finish(a, grp, lane, acc, ss); }
        __syncthreads();
    }
    const int gw = wave * G + bid, NGW = G * 8;
    CvtJob j0, j1; CvtRegs r0, r1;
    int it = gw; bool ok0 = cvt_decode(a, it, j0), ok1;
    if (ok0) cvt_load(j0, r0, lane);
    while (ok0) {
        ok1 = cvt_decode(a, it + NGW, j1); if (ok1) cvt_load(j1, r1, lane);
        cvt_store(j0, r0, scr, lane);
        if (!ok1) break;
        it += 2 * NGW; ok0 = cvt_decode(a, it, j0); if (ok0) cvt_load(j0, r0, lane);
        cvt_store(j1, r1, scr, lane);
    }
}

__device__ __forceinline__ s16x4 tr16(const LAS short* p) { return __builtin_amdgcn_ds_read_tr16_b64_v4i16((LAS s16x4*)p); }
__device__ __forceinline__ bf16x8 tr_frag(const LAS short* T, int pitch, int krow0, int col0, int lane) {
    const int g = lane >> 4, q = (lane & 15) >> 2, p = lane & 3;
    const LAS short* a0 = T + (krow0 + 8 * g + q) * pitch + col0 + 4 * p;
    const s16x4 lo = tr16(a0), hi = tr16(a0 + 4 * pitch);
    bf16x8 r; r[0] = lo[0]; r[1] = lo[1]; r[2] = lo[2]; r[3] = lo[3]; r[4] = hi[0]; r[5] = hi[1]; r[6] = hi[2]; r[7] = hi[3]; return r;
}
constexpr int PQ = 136, PV = 264, PP = 72;
constexpr int L_Q = 0, L_K = 17408, L_KW = 34816, L_V = 52224, L_P = 86016, L_F = 95232;
constexpr int L_G = 98816;
constexpr int F_B = 0, F_PM = 64, F_SI = 128, F_HD = 192, F_N = 256, F_SSQ = 384;

struct ChunkGates { float a, pm, b, wk, decay, m_new, b_last; };
struct GateScan { float a, b, cm, b_last, cm_last; };
__device__ __forceinline__ GateScan gate_scan(float ig, float lf, int lane) {
    GateScan g; float b = lf;
#pragma unroll
    for (int o = 1; o < 64; o <<= 1) { const float t = shi(b, lane >= o ? lane - o : lane); if (lane >= o) b += t; }
    const float av = ig - b; float cm = av;
#pragma unroll
    for (int o = 1; o < 64; o <<= 1) { const float t = shi(cm, lane >= o ? lane - o : lane); if (lane >= o) cm = fmaxf(cm, t); }
    g.a = av; g.b = b; g.cm = cm; g.b_last = shi(b, 63); g.cm_last = shi(cm, 63); return g;
}
__device__ __forceinline__ ChunkGates gate_finish(const GateScan& s, float m) {
    ChunkGates g; g.a = s.a; g.b = s.b; g.pm = fmaxf(m, s.cm); g.b_last = s.b_last;
    const float pml = fmaxf(m, s.cm_last);
    g.wk = __expf(s.a - pml); g.decay = __expf(m - pml); g.m_new = s.b_last + pml; return g;
}
__device__ __forceinline__ void item_gate_scans(const float* IG, const float* LF, size_t gbase, LAS unsigned char* lds, int lane, int wave) {
    LAS float* gq = (LAS float*)(lds + L_G);
    const GateScan s1 = gate_scan(IG[gbase + wave * 64 + lane], LF[gbase + wave * 64 + lane], lane);
    gq[wave * 64 + lane] = s1.a; gq[512 + wave * 64 + lane] = s1.b; gq[1024 + wave * 64 + lane] = s1.cm;
    if (lane == 0) { gq[1536 + 2 * wave] = s1.b_last; gq[1536 + 2 * wave + 1] = s1.cm_last; }
}
__device__ __forceinline__ GateScan chunk_scan_from_lds(LAS unsigned char* lds, int ch, int lane) {
    const LAS float* gq = (const LAS float*)(lds + L_G); GateScan g;
    g.a = gq[ch * 64 + lane]; g.b = gq[512 + ch * 64 + lane]; g.cm = gq[1024 + ch * 64 + lane]; g.b_last = gq[1536 + 2 * ch]; g.cm_last = gq[1536 + 2 * ch + 1]; return g;
}
__device__ __forceinline__ u32x4 scale_bf16x8(u32x4 v, float w) {
    u32x4 o; o.x = cvt_pk_bf16(bf_lo(v.x) * w, bf_hi(v.x) * w); o.y = cvt_pk_bf16(bf_lo(v.y) * w, bf_hi(v.y) * w); o.z = cvt_pk_bf16(bf_lo(v.z) * w, bf_hi(v.z) * w); o.w = cvt_pk_bf16(bf_lo(v.w) * w, bf_hi(v.w) * w); return o;
}
__device__ __forceinline__ void state_update(f32x4 (&C)[8][2], const bf16x8 (&Vf)[2][2], const LAS short* KWs, float decay, int lane) {
#pragma unroll
    for (int db = 0; db < 8; ++db) {
#pragma unroll
        for (int vb = 0; vb < 2; ++vb) C[db][vb] = C[db][vb] * decay;
#pragma unroll
        for (int ks = 0; ks < 2; ++ks) { const bf16x8 A = tr_frag(KWs, PQ, 32 * ks, 16 * db, lane);
#pragma unroll
            for (int vb = 0; vb < 2; ++vb) C[db][vb] = __builtin_amdgcn_mfma_f32_16x16x32_bf16(A, Vf[vb][ks], C[db][vb], 0, 0, 0); } }
}
__device__ __forceinline__ void mlstm_local(KA a, LAS unsigned char* lds, int tid, int lane, int wave) {
    LAS short* KWs = (LAS short*)(lds + L_KW); LAS short* Vs = (LAS short*)(lds + L_V); LAS float* fv = (LAS float*)(lds + L_F);
    const bf16_t* Kg = (const bf16_t*)(a.ws + WS_R0 + 32 * MiB); const bf16_t* Vg = (const bf16_t*)(a.ws + WS_R1);
    const float* IG = (const float*)(a.ws + WS_IG); const float* LF = (const float*)(a.ws + WS_LF);
    for (int item = blockIdx.x; item < 256; item += gridDim.x) {
        const int bh = item >> 4, sc = item & 15, b = bh >> 3, h = bh & 7;
        f32x4 C[8][2];
#pragma unroll
        for (int db = 0; db < 8; ++db) { C[db][0] = (f32x4){0.f, 0.f, 0.f, 0.f}; C[db][1] = (f32x4){0.f, 0.f, 0.f, 0.f}; }
        float m = -1e30f, btot = 0.f;
        __syncthreads();
        if (tid < 128) fv[F_N + tid] = 0.f;
        item_gate_scans(IG, LF, (size_t)bh * S_ + sc * 512, lds, lane, wave);
        u32x4 kreg[2], vreg[4];
        { const size_t row0 = (size_t)b * S_ + sc * 512;
#pragma unroll
          for (int i = 0; i < 2; ++i) { const int p = tid + 512 * i, r = p >> 4, pc = p & 15; kreg[i] = *(const u32x4*)(Kg + (row0 + r) * 1024 + h * 128 + pc * 8); }
#pragma unroll
          for (int i = 0; i < 4; ++i) { const int p = tid + 512 * i, r = p >> 5, pc = p & 31; vreg[i] = *(const u32x4*)(Vg + (row0 + r) * 2048 + h * 256 + pc * 8); }
        }
        __syncthreads();
        for (int ch = 0; ch < 8; ++ch) {
            const ChunkGates g = gate_finish(chunk_scan_from_lds(lds, ch, lane), m);
            __syncthreads();
#pragma unroll
            for (int i = 0; i < 2; ++i) { const int p = tid + 512 * i, r = p >> 4, pc = p & 15; *(LAS u32x4*)(KWs + r * PQ + pc * 8) = scale_bf16x8(kreg[i], shi(g.wk, r)); }
#pragma unroll
            for (int i = 0; i < 4; ++i) { const int p = tid + 512 * i, r = p >> 5, pc = p & 31; *(LAS u32x4*)(Vs + r * PV + pc * 8) = vreg[i]; }
            if (ch < 7) { const int t1 = sc * 512 + (ch + 1) * 64; const size_t row1 = (size_t)b * S_ + t1;
#pragma unroll
                for (int i = 0; i < 2; ++i) { const int p = tid + 512 * i, r = p >> 4, pc = p & 15; kreg[i] = *(const u32x4*)(Kg + (row1 + r) * 1024 + h * 128 + pc * 8); }
#pragma unroll
                for (int i = 0; i < 4; ++i) { const int p = tid + 512 * i, r = p >> 5, pc = p & 31; vreg[i] = *(const u32x4*)(Vg + (row1 + r) * 2048 + h * 256 + pc * 8); } }
            __syncthreads();
            bf16x8 Vf[2][2];
#pragma unroll
            for (int vb = 0; vb < 2; ++vb)
#pragma unroll
                for (int ks = 0; ks < 2; ++ks) Vf[vb][ks] = tr_frag(Vs, PV, 32 * ks, 32 * wave + 16 * vb, lane);
            state_update(C, Vf, KWs, g.decay, lane);
            if (tid < 128) { float s = 0.f;
#pragma unroll 8
                for (int s_ = 0; s_ < 64; ++s_) s += bf2f((unsigned short)KWs[s_ * PQ + tid]);
                fv[F_N + tid] = g.decay * fv[F_N + tid] + s; }
            m = g.m_new; btot += g.b_last;
        }
        float* CL = (float*)(a.ws + WS_CL) + (size_t)item * 32768;
#pragma unroll
        for (int db = 0; db < 8; ++db)
#pragma unroll
            for (int vb = 0; vb < 2; ++vb)
#pragma unroll
                for (int r = 0; r < 4; ++r) CL[((db * 2 + vb) * 4 + r) * 512 + tid] = C[db][vb][r];
        if (tid < 128) ((float*)(a.ws + WS_NL))[item * 128 + tid] = fv[F_N + tid];
        if (tid == 0) { ((float*)(a.ws + WS_ML))[item] = m; ((float*)(a.ws + WS_BT))[item] = btot; }
    }
}
__device__ __forceinline__ void mlstm_scan(KA a, int gtid, int nthr) {
    float* CL = (float*)(a.ws + WS_CL); float* NL = (float*)(a.ws + WS_NL);
    const float* ML = (const float*)(a.ws + WS_ML); const float* BT = (const float*)(a.ws + WS_BT); float* MS = (float*)(a.ws + WS_MS);
    for (int e = gtid; e < 16 * 32896; e += nthr) { const int bh = e / 32896, idx = e - bh * 32896; float c = 0.f, m = 0.f;
        float* p0 = idx < 32768 ? CL + (size_t)(bh * 16) * 32768 + idx : NL + (bh * 16) * 128 + (idx - 32768); const size_t pstep = idx < 32768 ? 32768 : 128;
        float loc[16], ml[16], bt[16];
#pragma unroll
        for (int j = 0; j < 16; ++j) { loc[j] = p0[j * pstep]; ml[j] = ML[bh * 16 + j]; bt[j] = BT[bh * 16 + j]; }
#pragma unroll
        for (int j = 0; j < 16; ++j) { p0[j * pstep] = c; if (idx == 0) MS[bh * 16 + j] = m;
            const float mn = fmaxf(bt[j] + m, ml[j]); c = __expf(bt[j] + m - mn) * c + __expf(ml[j] - mn) * loc[j]; m = mn; } }
}
__device__ __forceinline__ void mlstm_out(KA a, LAS unsigned char* lds, int tid, int lane_in, int wave) {
    LAS short* Qs = (LAS short*)(lds + L_Q); LAS short* Ks = (LAS short*)(lds + L_K); LAS short* KWs = (LAS short*)(lds + L_KW); LAS short* Vs = (LAS short*)(lds + L_V);
    LAS short* Ps = (LAS short*)(lds + L_P); LAS float* fv = (LAS float*)(lds + L_F);
    const bf16_t* Qg = (const bf16_t*)(a.ws + WS_R0); const bf16_t* Kg = (const bf16_t*)(a.ws + WS_R0 + 32 * MiB); const bf16_t* Vg = (const bf16_t*)(a.ws + WS_R1);
    const bf16_t* Og = (const bf16_t*)(a.ws + WS_R2); bf16_t* HG = (bf16_t*)(a.ws + WS_R3);
    const float* IG = (const float*)(a.ws + WS_IG); const float* LF = (const float*)(a.ws + WS_LF); const float* hnorm = a.in[I_MHN];
    for (int item = blockIdx.x; item < 256; item += gridDim.x) {
        const int bh = item >> 4, sc = item & 15, b = bh >> 3, h = bh & 7;
        f32x4 C[8][2];
        float m = ((const float*)(a.ws + WS_MS))[item];
        __syncthreads();
        if (tid < 128) fv[F_N + tid] = ((const float*)(a.ws + WS_NL))[item * 128 + tid];
        item_gate_scans(IG, LF, (size_t)bh * S_ + sc * 512, lds, lane_in, wave);
        u32x4 qreg[2], kreg[2], vreg[4]; u32x2 ocur[2][4];
        { const int lane = lane_in, tid = wave * 64 + lane; const size_t row0 = (size_t)b * S_ + sc * 512;
#pragma unroll
          for (int i = 0; i < 2; ++i) { const int p = tid + 512 * i, r = p >> 4, pc = p & 15; qreg[i] = *(const u32x4*)(Qg + (row0 + r) * 1024 + h * 128 + pc * 8); kreg[i] = *(const u32x4*)(Kg + (row0 + r) * 1024 + h * 128 + pc * 8); }
#pragma unroll
          for (int i = 0; i < 4; ++i) { const int p = tid + 512 * i, r = p >> 5, pc = p & 31; vreg[i] = *(const u32x4*)(Vg + (row0 + r) * 2048 + h * 256 + pc * 8); }
#pragma unroll
          for (int tb = 0; tb < 4; ++tb)
#pragma unroll
            for (int vb = 0; vb < 2; ++vb) ocur[vb][tb] = *(const u32x2*)(Og + (row0 + 16 * tb + (lane & 15)) * 2048 + h * 256 + 32 * wave + 16 * vb + 4 * (lane >> 4)); }
        { const float* CL = (const float*)(a.ws + WS_CL) + (size_t)item * 32768;
#pragma unroll
          for (int db = 0; db < 8; ++db)
#pragma unroll
            for (int vb = 0; vb < 2; ++vb)
#pragma unroll
                for (int r = 0; r < 4; ++r) C[db][vb][r] = CL[((db * 2 + vb) * 4 + r) * 512 + tid]; }
        __syncthreads();
        f32x4 hnr[2];
#pragma unroll
        for (int vb = 0; vb < 2; ++vb) hnr[vb] = *(const f32x4*)(hnorm + h * 256 + 32 * wave + 16 * vb + 4 * (lane_in >> 4));
        for (int ch = 0; ch < 8; ++ch) {
            const int lane = launder_v(lane_in), tid = wave * 64 + lane, l15 = lane & 15, g4 = lane >> 4;
            const int t0 = sc * 512 + ch * 64; const size_t row0 = (size_t)b * S_ + t0;
            const ChunkGates g = gate_finish(chunk_scan_from_lds(lds, ch, lane), m);
            const float si = __expf(m - g.pm);
            if (wave == 0) { fv[F_B + lane] = g.b; fv[F_PM + lane] = g.pm; fv[F_SI + lane] = si; }
#pragma unroll
            for (int i = 0; i < 2; ++i) { const int p = tid + 512 * i, r = p >> 4, pc = p & 15;
                *(LAS u32x4*)(Qs + r * PQ + pc * 8) = qreg[i]; *(LAS u32x4*)(Ks + r * PQ + pc * 8) = kreg[i]; *(LAS u32x4*)(KWs + r * PQ + pc * 8) = scale_bf16x8(kreg[i], shi(g.wk, r)); }
#pragma unroll
            for (int i = 0; i < 4; ++i) { const int p = tid + 512 * i, r = p >> 5, pc = p & 31; *(LAS u32x4*)(Vs + r * PV + pc * 8) = vreg[i]; }
            if (ch < 7) { const size_t row1 = row0 + 64;
#pragma unroll
                for (int i = 0; i < 2; ++i) { const int p = tid + 512 * i, r = p >> 4, pc = p & 15; qreg[i] = *(const u32x4*)(Qg + (row1 + r) * 1024 + h * 128 + pc * 8); kreg[i] = *(const u32x4*)(Kg + (row1 + r) * 1024 + h * 128 + pc * 8); }
#pragma unroll
                for (int i = 0; i < 4; ++i) { const int p = tid + 512 * i, r = p >> 5, pc = p & 31; vreg[i] = *(const u32x4*)(Vg + (row1 + r) * 2048 + h * 256 + pc * 8); }
 }
            __syncthreads();
            { const int tb = wave >> 1, t = 16 * tb + l15; const float pm_t = shi(g.pm, t);
#pragma unroll
              for (int xx = 0; xx < 2; ++xx) { const int sb = 2 * (wave & 1) + xx; f32x4 sacc = {0.f, 0.f, 0.f, 0.f};
                if (sb <= tb) {
#pragma unroll
                    for (int ks = 0; ks < 4; ++ks) { const bf16x8 A = *(const LAS bf16x8*)(Ks + (16 * sb + l15) * PQ + 32 * ks + 8 * g4), B = *(const LAS bf16x8*)(Qs + t * PQ + 32 * ks + 8 * g4);
                        sacc = __builtin_amdgcn_mfma_f32_16x16x32_bf16(A, B, sacc, 0, 0, 0); } }
                float p[4];
#pragma unroll
                for (int r = 0; r < 4; ++r) { const int s = 16 * sb + 4 * g4 + r; const float a_s = shi(g.a, s); p[r] = (s <= t) ? sacc[r] * __expf(a_s - pm_t) : 0.f; }
                u32x2 w; w.x = cvt_pk_bf16(p[0], p[1]); w.y = cvt_pk_bf16(p[2], p[3]); *(LAS u32x2*)(Ps + t * PP + 16 * sb + 4 * g4) = w; } }
            __syncthreads();
            f32x4 acc[2][4];
#pragma unroll
            for (int vb = 0; vb < 2; ++vb)
#pragma unroll
                for (int tb = 0; tb < 4; ++tb) acc[vb][tb] = (f32x4){0.f, 0.f, 0.f, 0.f};
#pragma unroll
            for (int ks = 0; ks < 4; ++ks) { bf16x8 Cf[2];
#pragma unroll
                for (int vb = 0; vb < 2; ++vb) { u32x4 w; const f32x4 c0 = C[2 * ks][vb], c1 = C[2 * ks + 1][vb];
                    w.x = cvt_pk_bf16(c0[0], c0[1]); w.y = cvt_pk_bf16(c0[2], c0[3]); w.z = cvt_pk_bf16(c1[0], c1[1]); w.w = cvt_pk_bf16(c1[2], c1[3]); Cf[vb] = __builtin_bit_cast(bf16x8, w); }
#pragma unroll
                for (int tb = 0; tb < 4; ++tb) { const LAS short* qp = Qs + (16 * tb + l15) * PQ + 32 * ks + 4 * g4; const u32x2 q0 = *(const LAS u32x2*)qp, q1 = *(const LAS u32x2*)(qp + 16);
                    u32x4 qw; qw.x = q0.x; qw.y = q0.y; qw.z = q1.x; qw.w = q1.y; const bf16x8 Qf = __builtin_bit_cast(bf16x8, qw);
#pragma unroll
                    for (int vb = 0; vb < 2; ++vb) acc[vb][tb] = __builtin_amdgcn_mfma_f32_16x16x32_bf16(Cf[vb], Qf, acc[vb][tb], 0, 0, 0); } }
#pragma unroll
            for (int tb = 0; tb < 4; ++tb) { const float si_t = shi(si, 16 * tb + l15); acc[0][tb] = acc[0][tb] * si_t; acc[1][tb] = acc[1][tb] * si_t; }
            bf16x8 Vf[2][2];
#pragma unroll
            for (int vb = 0; vb < 2; ++vb)
#pragma unroll
                for (int ks = 0; ks < 2; ++ks) Vf[vb][ks] = tr_frag(Vs, PV, 32 * ks, 32 * wave + 16 * vb, lane);
#pragma unroll
            for (int ks = 0; ks < 2; ++ks)
#pragma unroll
                for (int tb = 0; tb < 4; ++tb) { const bf16x8 Pf = *(const LAS bf16x8*)(Ps + (16 * tb + l15) * PP + 32 * ks + 8 * g4);
#pragma unroll
                    for (int vb = 0; vb < 2; ++vb) acc[vb][tb] = __builtin_amdgcn_mfma_f32_16x16x32_bf16(Vf[vb][ks], Pf, acc[vb][tb], 0, 0, 0); }
            { const int t = tid >> 3, part = tid & 7; const u32x4 pw = *(const LAS u32x4*)(Ps + t * PP + 8 * part);
              const float psum = (bf_lo(pw.x) + bf_hi(pw.x)) + (bf_lo(pw.y) + bf_hi(pw.y)) + (bf_lo(pw.z) + bf_hi(pw.z)) + (bf_lo(pw.w) + bf_hi(pw.w));
              const u32x4 qa = *(const LAS u32x4*)(Qs + t * PQ + 16 * part), qb = *(const LAS u32x4*)(Qs + t * PQ + 16 * part + 8); const LAS float* nv = fv + F_N + 16 * part;
              float qn = bf_lo(qa.x) * nv[0] + bf_hi(qa.x) * nv[1] + bf_lo(qa.y) * nv[2] + bf_hi(qa.y) * nv[3] + bf_lo(qa.z) * nv[4] + bf_hi(qa.z) * nv[5] + bf_lo(qa.w) * nv[6] + bf_hi(qa.w) * nv[7]
                       + bf_lo(qb.x) * nv[8] + bf_hi(qb.x) * nv[9] + bf_lo(qb.y) * nv[10] + bf_hi(qb.y) * nv[11] + bf_lo(qb.z) * nv[12] + bf_hi(qb.z) * nv[13] + bf_lo(qb.w) * nv[14] + bf_hi(qb.w) * nv[15];
              float den = psum + fv[F_SI + t] * qn; den += shx(den, 1, lane); den += shx(den, 2, lane); den += shx(den, 4, lane);
              if (part == 0) fv[F_HD + t] = __builtin_amdgcn_rcpf(fmaxf(fabsf(den), __expf(-(fv[F_B + t] + fv[F_PM + t])))); }
            __syncthreads();
#pragma unroll
            for (int tb = 0; tb < 4; ++tb) { const float hd = fv[F_HD + 16 * tb + l15]; float ss = 0.f;
#pragma unroll
                for (int vb = 0; vb < 2; ++vb) { acc[vb][tb] = acc[vb][tb] * hd; const f32x4 v = acc[vb][tb]; ss += (v[0] * v[0] + v[1] * v[1]) + (v[2] * v[2] + v[3] * v[3]); }
                ss += shx(ss, 16, lane); ss += shx(ss, 32, lane);
                if (lane < 16) fv[F_SSQ + wave * 64 + 16 * tb + lane] = ss; }
            if (tid < 128) { float s = 0.f;
#pragma unroll 8
                for (int s_ = 0; s_ < 64; ++s_) s += bf2f((unsigned short)KWs[s_ * PQ + tid]);
                fv[F_N + tid] = g.decay * fv[F_N + tid] + s; }
            state_update(C, Vf, KWs, g.decay, lane);
            __syncthreads();
#pragma unroll
            for (int tb = 0; tb < 4; ++tb) { const int t = 16 * tb + l15; float tot = 0.f;
#pragma unroll
                for (int w = 0; w < 8; ++w) tot += fv[F_SSQ + w * 64 + t];
                const float rs = rsqrtf(tot * (1.0f / 256.0f) + RMS_EPS);
#pragma unroll
                for (int vb = 0; vb < 2; ++vb) { const int col = h * 256 + 32 * wave + 16 * vb + 4 * g4; const f32x4 hn = hnr[vb];
                    const u32x2 ow = ocur[vb][tb]; const f32x4 v = acc[vb][tb];
                    u32x2 w; w.x = cvt_pk_bf16(v[0] * rs * hn[0] * bf_lo(ow.x), v[1] * rs * hn[1] * bf_hi(ow.x)); w.y = cvt_pk_bf16(v[2] * rs * hn[2] * bf_lo(ow.y), v[3] * rs * hn[3] * bf_hi(ow.y));
                    *(u32x2*)(HG + (row0 + t) * 2048 + col) = w; } }
            m = g.m_new;
            if (ch < 7) {
#pragma unroll
                for (int tb = 0; tb < 4; ++tb)
#pragma unroll
                    for (int vb = 0; vb < 2; ++vb) ocur[vb][tb] = *(const u32x2*)(Og + (row0 + 64 + 16 * tb + l15) * 2048 + h * 256 + 32 * wave + 16 * vb + 4 * g4); }
        }
    }
}

__device__ __forceinline__ void rg_conv(KA a, int gtid, int nthr) {
    const bf16_t* REC = (const bf16_t*)(a.ws + WS_R1); bf16_t* XC = (bf16_t*)(a.ws + WS_R2); const float* cw = a.in[I_RCW]; const float* cb = a.in[I_RCB];
    for (int e = gtid; e < (M_ / 16) * 256; e += nthr) { const int rg = e >> 8, c0 = (e & 255) * 8, row0 = rg * 16, t0 = row0 & (S_ - 1);
        u32x4 v[19];
#pragma unroll
        for (int i = 0; i < 19; ++i) { if (t0 + i - 3 >= 0) v[i] = *(const u32x4*)(REC + (size_t)(row0 + i - 3) * 2048 + c0); else v[i] = (u32x4){0u, 0u, 0u, 0u}; }
        f32x4 w0[4], w1[4];
#pragma unroll
        for (int j = 0; j < 4; ++j) { w0[j] = *(const f32x4*)(cw + j * 2048 + c0); w1[j] = *(const f32x4*)(cw + j * 2048 + c0 + 4); }
        const f32x4 b0 = *(const f32x4*)(cb + c0), b1 = *(const f32x4*)(cb + c0 + 4);
#pragma unroll
        for (int r = 0; r < 16; ++r) { f32x4 o0 = b0, o1 = b1;
#pragma unroll
            for (int j = 0; j < 4; ++j) { const u32x4 x = v[r + j];
                o0[0] += w0[j][0] * bf_lo(x.x); o0[1] += w0[j][1] * bf_hi(x.x); o0[2] += w0[j][2] * bf_lo(x.y); o0[3] += w0[j][3] * bf_hi(x.y);
                o1[0] += w1[j][0] * bf_lo(x.z); o1[1] += w1[j][1] * bf_hi(x.z); o1[2] += w1[j][2] * bf_lo(x.w); o1[3] += w1[j][3] * bf_hi(x.w); }
            u32x4 w; w.x = cvt_pk_bf16(o0[0], o0[1]); w.y = cvt_pk_bf16(o0[2], o0[3]); w.z = cvt_pk_bf16(o1[0], o1[1]); w.w = cvt_pk_bf16(o1[2], o1[3]);
            *(u32x4*)(XC + (size_t)(row0 + r) * 2048 + c0) = w; } }
}
__device__ __forceinline__ void rg_scan1(KA a, int gtid, int nthr) {
    const bf16_t* LA = (const bf16_t*)(a.ws + WS_R3); const bf16_t* U = (const bf16_t*)(a.ws + WS_R1); float* SP = (float*)(a.ws + WS_SP); float* SH = (float*)(a.ws + WS_SH);
    for (int it = gtid; it < 131072; it += nthr) { const int c = (it & 1023) * 2, j = (it >> 10) & 63, b = it >> 16; const size_t base = ((size_t)b * S_ + j * 128) * 2048 + c;
        float h0 = 0.f, h1 = 0.f, s0 = 0.f, s1 = 0.f; unsigned la[2][16], uu[2][16];
#pragma unroll
        for (int t = 0; t < 16; ++t) { la[0][t] = *(const unsigned*)(LA + base + (size_t)t * 2048); uu[0][t] = *(const unsigned*)(U + base + (size_t)t * 2048); }
#pragma unroll
        for (int bt = 0; bt < 8; ++bt) { const int cur = bt & 1, nxt = cur ^ 1;
            if (bt < 7) {
#pragma unroll
                for (int t = 0; t < 16; ++t) { const size_t off = base + (size_t)((bt + 1) * 16 + t) * 2048; la[nxt][t] = *(const unsigned*)(LA + off); uu[nxt][t] = *(const unsigned*)(U + off); } }
#pragma unroll
            for (int t = 0; t < 16; ++t) { const float l0 = bf_lo(la[cur][t]), l1 = bf_hi(la[cur][t]); s0 += l0; s1 += l1; h0 = __expf(l0) * h0 + bf_lo(uu[cur][t]); h1 = __expf(l1) * h1 + bf_hi(uu[cur][t]); } }
        const size_t o = ((size_t)b * 64 + j) * 2048 + c; SP[o] = s0; SP[o + 1] = s1; SH[o] = h0; SH[o + 1] = h1; }
}
__device__ __forceinline__ void rg_scan2(KA a, int gtid, int nthr) {
    const bf16_t* LA = (const bf16_t*)(a.ws + WS_R3); const bf16_t* U = (const bf16_t*)(a.ws + WS_R1); const bf16_t* GG = (const bf16_t*)(a.ws + WS_R0); bf16_t* YB = (bf16_t*)(a.ws + WS_R2);
    const float* SP = (const float*)(a.ws + WS_SP); const float* SH = (const float*)(a.ws + WS_SH);
    for (int it = gtid; it < 131072; it += nthr) { const int c = (it & 1023) * 2, j = (it >> 10) & 63, b = it >> 16; const size_t base = ((size_t)b * S_ + j * 128) * 2048 + c;
        unsigned la[2][16], uu[2][16], gg[2][16];
#pragma unroll
        for (int t = 0; t < 16; ++t) { const size_t off = base + (size_t)t * 2048; la[0][t] = *(const unsigned*)(LA + off); uu[0][t] = *(const unsigned*)(U + off); gg[0][t] = *(const unsigned*)(GG + off); }
        float h0 = 0.f, h1 = 0.f;
        for (int j0 = 0; j0 < j; j0 += 8) { f32x2_ sp[8], sh[8];
#pragma unroll
            for (int q = 0; q < 8; ++q) { const size_t o = ((size_t)b * 64 + (j0 + q < j ? j0 + q : 0)) * 2048 + c; sp[q] = *(const f32x2_*)(SP + o); sh[q] = *(const f32x2_*)(SH + o); }
#pragma unroll
            for (int q = 0; q < 8; ++q) if (j0 + q < j) { h0 = __expf(sp[q].x) * h0 + sh[q].x; h1 = __expf(sp[q].y) * h1 + sh[q].y; } }
#pragma unroll
        for (int bt = 0; bt < 8; ++bt) { const int cur = bt & 1, nxt = cur ^ 1;
            if (bt < 7) {
#pragma unroll
                for (int t = 0; t < 16; ++t) { const size_t off = base + (size_t)((bt + 1) * 16 + t) * 2048; la[nxt][t] = *(const unsigned*)(LA + off); uu[nxt][t] = *(const unsigned*)(U + off); gg[nxt][t] = *(const unsigned*)(GG + off); } }
#pragma unroll
            for (int t = 0; t < 16; ++t) { const size_t off = base + (size_t)(bt * 16 + t) * 2048;
                h0 = __expf(bf_lo(la[cur][t])) * h0 + bf_lo(uu[cur][t]); h1 = __expf(bf_hi(la[cur][t])) * h1 + bf_hi(uu[cur][t]);
                *(unsigned*)(YB + off) = cvt_pk_bf16(bf_lo(gg[cur][t]) * h0, bf_hi(gg[cur][t]) * h1); } }
    }
}
__device__ __forceinline__ void final_norm(KA a, int gw, int NGW, int lane) {
    const float* ssqp = (const float*)(a.ws + WS_SSQ) + 4 * SSQ_STAGE; const float* gf = a.in[I_NFIN]; const bf16_t* HBp = (const bf16_t*)(a.ws + WS_HB);
    f32x4 g[8];
#pragma unroll
    for (int i = 0; i < 4; ++i) { g[2 * i] = *(const f32x4*)(gf + i * 512 + lane * 8); g[2 * i + 1] = *(const f32x4*)(gf + i * 512 + lane * 8 + 4); }
    for (int row = gw; row < M_; row += NGW) {
        float t = ssqp[(size_t)row * 32 + (lane & 31)];
        u32x4 v[4];
#pragma unroll
        for (int i = 0; i < 4; ++i) v[i] = *(const u32x4*)(HBp + (size_t)row * 2048 + i * 512 + lane * 8);
#pragma unroll
        for (int o = 1; o < 32; o <<= 1) t += shx(t, o, lane);
        const float r = rsqrtf(t * (1.0f / 2048.0f) + RMS_EPS);
#pragma unroll
        for (int i = 0; i < 4; ++i) { float* o = a.out + (size_t)row * 2048 + i * 512 + lane * 8; const f32x4 g0 = g[2 * i], g1 = g[2 * i + 1];
            *(f32x4*)o = (f32x4){bf_lo(v[i].x) * r * g0[0], bf_hi(v[i].x) * r * g0[1], bf_lo(v[i].y) * r * g0[2], bf_hi(v[i].y) * r * g0[3]};
            *(f32x4*)(o + 4) = (f32x4){bf_lo(v[i].z) * r * g1[0], bf_hi(v[i].z) * r * g1[1], bf_lo(v[i].w) * r * g1[2], bf_hi(v[i].w) * r * g1[3]}; }
    }
}

#define GRID_BAR() do { XcdBarrier xb_ = xbar; asm volatile("" : "+s"(xb_.bar), "+s"(xb_.x)); xcd_barrier(xb_); } while (0)
#ifndef REP_NULL
#define REP_NULL 0
#endif
#ifndef REP_SCAN
#define REP_SCAN 1
#endif
#ifndef REP_GATES
#define REP_GATES 1
#endif
#ifndef REP_CONV
#define REP_CONV 1
#endif
#ifndef REP_MLL
#define REP_MLL 1
#endif
#ifndef REP_MLO
#define REP_MLO 1
#endif
#ifndef REP_PRO
#define REP_PRO 1
#endif
#ifndef REP_G1
#define REP_G1 1
#endif
#ifndef REP_ML
#define REP_ML 1
#endif
#ifndef REP_FFN
#define REP_FFN 1
#endif
#ifndef REP_RG
#define REP_RG 1
#endif
#ifndef REP_G5
#define REP_G5 1
#endif
#ifndef EXTRA_SYNC
#define EXTRA_SYNC 0
#endif
__global__ void __launch_bounds__(NTHR, 2) fwd_megakernel(Args a_by_value) {
    extern __shared__ __attribute__((aligned(16))) unsigned char lds_raw[];
    LAS unsigned char* lds = (LAS unsigned char*)lds_raw;
    cg::grid_group grid = cg::this_grid();
    if (threadIdx.x == 0) { ((volatile LAS unsigned*)(lds + LDS_MISC))[0] = 0u; ((volatile LAS unsigned*)(lds + LDS_MISC))[1] = 0u; }
    __syncthreads();
    const XcdBarrier xbar = xcd_barrier_post((unsigned*)(a_by_value.ws + WS_BAR), (volatile LAS unsigned*)(lds + LDS_MISC));
    const int wave0 = __builtin_amdgcn_readfirstlane(threadIdx.x >> 6);
#define KARGS() const __attribute__((address_space(4))) Args* kap_ = (const __attribute__((address_space(4))) Args*)__builtin_amdgcn_kernarg_segment_ptr(); asm volatile("" : "+s"(kap_)); KA a = *kap_
#define IDS() KARGS(); const int lane = launder_v(__builtin_amdgcn_mbcnt_hi(~0u, __builtin_amdgcn_mbcnt_lo(~0u, 0u))), wave = launder_s(wave0), tid = wave * 64 + lane, bid = launder_s(blockIdx.x), gtid = bid * NTHR + tid; (void)lane; (void)wave; (void)gtid
    const int G = gridDim.x, nthr = G * NTHR;
#define ssq ((float*)(a.ws + WS_SSQ))
#define HB ((bf16_t*)(a.ws + WS_HB))

    for (int rep = 0; rep < REP_PRO; ++rep) { { IDS(); prologue(a, lds, bid, G, lane, wave); }
    GRID_BAR(); }
    if (gridDim.x > 65536u) grid.sync();
    for (int rep = 0; rep < EXTRA_SYNC; ++rep) GRID_BAR();
#define GEMM_RES(AOFF, WOFF, KK, SSQI) { KARGS(); pg8::Gemm g{(const bf16_t*)(a.ws + (AOFF)), (const bf16_t*)(a.ws + (WOFF)), M_, 2048, (KK), (KK), (KK), wave0}; pg8::StaticOrder S; S.init(M_, 2048, G, (int)blockIdx.x); \
        pg8::EpiResidual E{HB, ssq + (size_t)(SSQI) * SSQ_STAGE}; pg8::gemm_phase<pg8::EpiResidual, pg8::StaticOrder, true, true>(lds, g, S, E); } GRID_BAR()
#define GEMM_FFN_IN(WOFF, SSQI) { KARGS(); pg8::Gemm g{HB, (const bf16_t*)(a.ws + (WOFF)), M_, 2 * DFF_, 2048, 2048, 2048, wave0}; pg8::StaticOrder S; S.init(M_, 2 * DFF_, G, (int)blockIdx.x); \
        pg8::EpiSwiglu E{(bf16_t*)(a.ws + WS_R0), ssq + (size_t)(SSQI) * SSQ_STAGE}; pg8::gemm_phase<pg8::EpiSwiglu, pg8::StaticOrder, true, true>(lds, g, S, E); } GRID_BAR()
    for (int rep = 0; rep < REP_G1; ++rep) { if (rep) GRID_BAR(); KARGS(); pg8::Gemm g{HB, (const bf16_t*)(a.ws + WS_WM_IN), M_, 6144, 2048, 2048, 2048, wave0}; pg8::StaticOrder S; S.init(M_, 6144, G, (int)blockIdx.x);
      pg8::EpiMlstmIn E{(bf16_t*)(a.ws + WS_R0), (bf16_t*)(a.ws + WS_R0 + 32 * MiB), (bf16_t*)(a.ws + WS_R1), (bf16_t*)(a.ws + WS_R2), ssq};
      pg8::gemm_phase<pg8::EpiMlstmIn, pg8::StaticOrder, true, true>(lds, g, S, E); }
    GRID_BAR();
    for (int rep = 0; rep < REP_ML * REP_MLL; ++rep) { { IDS(); mlstm_local(a, lds, tid, lane, wave); }
    GRID_BAR(); }
    { IDS(); mlstm_scan(a, gtid, nthr); }
    GRID_BAR();
    for (int rep = 0; rep < REP_ML * REP_MLO; ++rep) { { IDS(); mlstm_out(a, lds, tid, lane, wave); }
    GRID_BAR(); }
    GEMM_RES(WS_R3, WS_WM_OUT, 2048, 1);
    for (int rep = 0; rep < REP_FFN; ++rep) { GEMM_FFN_IN(WS_WF_IN0, 1); }
    for (int rep = 0; rep < REP_NULL; ++rep) { { KARGS(); pg8::Gemm g{HB, (const bf16_t*)(a.ws + WS_WF_IN0), M_, 2 * DFF_, 2048, 2048, 2048, wave0}; pg8::StaticOrder S; S.init(M_, 2 * DFF_, G, (int)blockIdx.x);
        pg8::EpiNull E{(float*)(a.ws + WS_SP)}; pg8::gemm_phase<pg8::EpiNull, pg8::StaticOrder, true, true>(lds, g, S, E); } GRID_BAR(); }
    GEMM_RES(WS_R0, WS_WF_OUT0, DFF_, 2);
    for (int rep = 0; rep < REP_G5; ++rep) { if (rep) GRID_BAR(); KARGS(); pg8::Gemm g{HB, (const bf16_t*)(a.ws + WS_WR_IN), M_, 4096, 2048, 2048, 2048, wave0}; pg8::StaticOrder S; S.init(M_, 4096, G, (int)blockIdx.x);
      pg8::EpiRgIn E{(bf16_t*)(a.ws + WS_R0), (bf16_t*)(a.ws + WS_R1), ssq + 2 * SSQ_STAGE};
      pg8::gemm_phase<pg8::EpiRgIn, pg8::StaticOrder, true, true>(lds, g, S, E); }
    GRID_BAR();
    for (int rep = 0; rep < REP_RG * REP_CONV; ++rep) { { IDS(); rg_conv(a, gtid, nthr); }
    GRID_BAR(); }
    for (int rep = 0; rep < REP_RG * REP_GATES; ++rep) { if (rep) GRID_BAR(); KARGS(); pg8::Gemm g{(const bf16_t*)(a.ws + WS_R2), (const bf16_t*)(a.ws + WS_WG), M_, 4096, 256, 2048, 256, wave0}; pg8::GateOrder S; S.init(M_, 4096, G, (int)blockIdx.x);
      pg8::EpiRgGates E{(const bf16_t*)(a.ws + WS_R2), (bf16_t*)(a.ws + WS_R3), (bf16_t*)(a.ws + WS_R1), a.in[I_RGB], a.in[I_RAP]};
      pg8::gemm_phase<pg8::EpiRgGates, pg8::GateOrder, true, true>(lds, g, S, E); }
    GRID_BAR();
    for (int rep = 0; rep < REP_RG * REP_SCAN; ++rep) { { IDS(); rg_scan1(a, gtid, nthr); }
    GRID_BAR(); }
    for (int rep = 0; rep < REP_RG * REP_SCAN; ++rep) { { IDS(); rg_scan2(a, gtid, nthr); }
    GRID_BAR(); }
    GEMM_RES(WS_R2, WS_WR_OUT, 2048, 3);
    for (int rep = 0; rep < REP_FFN; ++rep) { GEMM_FFN_IN(WS_WF_IN1, 3); }
    GEMM_RES(WS_R0, WS_WF_OUT1, DFF_, 4);
    { IDS(); final_norm(a, bid * 8 + wave, G * 8, lane); }
}

extern "C" void kernel_launch(void* const* d_in, const int* in_sizes, int n_in, void* d_out, int out_size, void* d_ws, size_t ws_size, hipStream_t stream) {
    static int grid = 0;
    if (grid == 0) {
        if (n_in != 17 || out_size != M_ * D_ || ws_size < WS_END) { fprintf(stderr, "kernel_launch: unexpected problem (n_in %d, out %d, ws %zu)\n", n_in, out_size, ws_size); grid = -1; return; }
        int dev = 0, cus = 0, per_cu = 0;
        hipGetDevice(&dev); hipDeviceGetAttribute(&cus, hipDeviceAttributeMultiprocessorCount, dev);
        hipFuncSetAttribute((const void*)fwd_megakernel, hipFuncAttributeMaxDynamicSharedMemorySize, LDS_BYTES);
        hipOccupancyMaxActiveBlocksPerMultiprocessor(&per_cu, (const void*)fwd_megakernel, NTHR, LDS_BYTES);
        if (per_cu < 1) { fprintf(stderr, "kernel_launch: occupancy query says %d blocks per CU\n", per_cu); per_cu = 1; }
        (void)hipGetLastError();
        grid = cus * 1;
    }
    if (grid < 0) return;
    Args a{};
    for (int i = 0; i < 17; ++i) a.in[i] = (const float*)d_in[i];
    a.out = (float*)d_out; a.ws = (unsigned char*)d_ws;
    (void)hipMemsetAsync((char*)d_ws + WS_BAR, 0, BAR_BYTES, stream);
    void* args[] = {&a};
    hipError_t e = hipLaunchCooperativeKernel((const void*)fwd_megakernel, dim3(grid), dim3(NTHR), args, LDS_BYTES, stream);
    if (e != hipSuccess) fprintf(stderr, "cooperative launch failed: %s (grid %d)\n", hipGetErrorString(e), grid);
}
```
